# Optimizing an MI355X kernel written in HIP

```python
import math
import jax
import jax.numpy as jnp
from jax import lax
import numpy as np

D_MODEL = 2048
BATCH = 4
SEQ = 2048
DEPTH = 2

GRID_W = 64
CTX_LEN = 256
Q_BLOCK = 128
EPS = 1e-6
ROPE_BASE = 10000.0
N_MOD = 6

DA_HEADS = 6
DA_HALF_DIM = 64
DA_V_DIM = 2 * DA_HALF_DIM
DA_WIDTH = DA_HEADS * DA_V_DIM

POOL_WINDOWS = (2, 4, 8, 16)
POOL_GROUP_DIM = 128
POOL_WIDTH = len(POOL_WINDOWS) * POOL_GROUP_DIM

GQA_Q_HEADS = 6
GQA_KV_HEADS = 2
GQA_GROUP = GQA_Q_HEADS // GQA_KV_HEADS
GQA_HEAD_DIM = 128
GQA_WIDTH = GQA_Q_HEADS * GQA_HEAD_DIM

MIX_WIDTH = DA_WIDTH + POOL_WIDTH + GQA_WIDTH

IN_SIZES = (DA_HEADS * 2 * DA_HALF_DIM, DA_HEADS * 2 * DA_HALF_DIM, DA_HEADS * DA_V_DIM,
            POOL_WIDTH, GQA_WIDTH, GQA_KV_HEADS * GQA_HEAD_DIM, GQA_KV_HEADS * GQA_HEAD_DIM)
IN_COLS = sum(IN_SIZES)
IN_SPLITS = tuple(sum(IN_SIZES[:i + 1]) for i in range(len(IN_SIZES) - 1))

D_FF = 5632
CONV_W = 3

kernel_name = "hybrid_diffattn_pool_gqa_convffn_prefix_dit"


def rms_norm(x, gain):
    xf = x.astype(jnp.float32)
    y = xf * lax.rsqrt(jnp.mean(xf * xf, axis=-1, keepdims=True) + EPS)
    return (y * gain.astype(jnp.float32)).astype(x.dtype)


def modulate(x, gain, shift, scale):
    return rms_norm(x, gain) * (1.0 + scale) + shift


def axial_angles(row, col, rot_dim):
    axis_dim = rot_dim // 2
    freqs = ROPE_BASE ** (-(jnp.arange(axis_dim // 2, dtype=jnp.float32) * 2.0 / axis_dim))
    return row[:, None] * freqs, col[:, None] * freqs


def rope_1d(x, ang):
    x1, x2 = jnp.split(x, 2, axis=-1)
    cos = jnp.cos(ang).astype(x.dtype)
    sin = jnp.sin(ang).astype(x.dtype)
    return jnp.concatenate([x1 * cos - x2 * sin, x2 * cos + x1 * sin], axis=-1)


def rope_2d(x, ang_row, ang_col):
    xr, xc = jnp.split(x, 2, axis=-1)
    return jnp.concatenate([rope_1d(xr, ang_row), rope_1d(xc, ang_col)], axis=-1)


def rope_da(t, ang):
    t1, t2 = jnp.split(t, 2, axis=-1)
    return jnp.concatenate([rope_2d(t1, *ang), rope_2d(t2, *ang)], axis=-1)


def block_attention(q, k, v):
    b, hk, g, sq, dk = q.shape
    nb = sq // Q_BLOCK
    scale = dk ** -0.5
    qb = q.reshape(b, hk, g, nb, Q_BLOCK, dk).transpose(3, 0, 1, 2, 4, 5)

    def one_block(qblk):
        s = jnp.einsum('bhgqd,bhkd->bhgqk', qblk, k).astype(jnp.float32) * scale
        p = jax.nn.softmax(s, axis=-1).astype(v.dtype)
        return jnp.einsum('bhgqk,bhkd->bhgqd', p, v)

    out = lax.map(one_block, qb)
    return out.transpose(1, 2, 3, 0, 4, 5).reshape(b, hk, g, sq, v.shape[-1])


def diff_attention(q, k, v, lam, subln, lambda_init):
    d = DA_HALF_DIM
    a1 = block_attention(q[:, :, None, :, :d], k[..., :d], v)
    a2 = block_attention(q[:, :, None, :, d:], k[..., d:], v)
    o = (a1 - lam.astype(a1.dtype) * a2)[:, :, 0]
    o = rms_norm(o, subln) * (1.0 - lambda_init)
    b, h, sq, dv = o.shape
    return o.transpose(0, 2, 1, 3).reshape(b, sq, h * dv)


def gqa_attention(q, k, v):
    b, _, sq, d = q.shape
    o = block_attention(q.reshape(b, GQA_KV_HEADS, GQA_GROUP, sq, d), k, v)
    return o.reshape(b, GQA_Q_HEADS, sq, d).transpose(0, 2, 1, 3).reshape(b, sq, GQA_WIDTH)


def pool_mixer(u, w_pool, pool_scale):
    b, t, _ = u.shape
    uf = u.astype(jnp.float32)
    cs = jnp.pad(jnp.cumsum(uf, axis=1), ((0, 0), (1, 0), (0, 0)))
    pos = jnp.arange(t)
    outs = []
    for g, w in enumerate(POOL_WINDOWS):
        lo = jnp.clip(pos - w // 2, 0, t)
        hi = jnp.clip(pos - w // 2 + w, 0, t)
        csg = cs[..., g * POOL_GROUP_DIM:(g + 1) * POOL_GROUP_DIM]
        mean = (csg[:, hi] - csg[:, lo]) / (hi - lo).astype(jnp.float32)[None, :, None]
        outs.append(mean - uf[..., g * POOL_GROUP_DIM:(g + 1) * POOL_GROUP_DIM])
    pooled = jnp.stack(outs, axis=2).astype(u.dtype)
    mixed = jnp.einsum('btgc,gcd->btgd', pooled, w_pool).reshape(b, t, POOL_WIDTH)
    return mixed * pool_scale


def token_mixer(h_ctx, h_lat, ang_da, ang_gqa, lp, lambda_init, with_ctx_out):
    b, n_ctx, _ = h_ctx.shape
    n_tok = n_ctx + h_lat.shape[1]
    proj = jnp.concatenate([h_ctx, h_lat], axis=1) @ lp['w_in']
    da_q, da_k, da_v, pool_in, g_q, g_k, g_v = jnp.split(proj, IN_SPLITS, axis=-1)

    def heads(t, n, d):
        return t.reshape(b, n_tok, n, d).transpose(0, 2, 1, 3)

    q = heads(da_q, DA_HEADS, 2 * DA_HALF_DIM)
    k = heads(da_k, DA_HEADS, 2 * DA_HALF_DIM)
    v = heads(da_v, DA_HEADS, DA_V_DIM)
    q_lat = rope_da(q[:, :, n_ctx:], ang_da)
    k_all = jnp.concatenate([k[:, :, :n_ctx], rope_da(k[:, :, n_ctx:], ang_da)], axis=2)
    f32 = jnp.float32
    lam = (jnp.exp(jnp.sum(lp['lq1'].astype(f32) * lp['lk1'].astype(f32)))
           - jnp.exp(jnp.sum(lp['lq2'].astype(f32) * lp['lk2'].astype(f32))) + lambda_init)

    gq = rms_norm(heads(g_q, GQA_Q_HEADS, GQA_HEAD_DIM), lp['q_norm'])
    gk = rms_norm(heads(g_k, GQA_KV_HEADS, GQA_HEAD_DIM), lp['k_norm'])
    gv = heads(g_v, GQA_KV_HEADS, GQA_HEAD_DIM)
    gq_lat = rope_2d(gq[:, :, n_ctx:], *ang_gqa)
    gk_all = jnp.concatenate([gk[:, :, :n_ctx], rope_2d(gk[:, :, n_ctx:], *ang_gqa)], axis=2)

    def merge(o_da, o_pool, o_gqa):
        return jnp.concatenate([o_da, o_pool, rms_norm(o_gqa, lp['gqa_out_norm'])], axis=-1) @ lp['w_out']

    y_lat = merge(diff_attention(q_lat, k_all, v, lam, lp['subln'], lambda_init),
                  pool_mixer(pool_in[:, n_ctx:], lp['w_pool'], lp['pool_scale']),
                  gqa_attention(gq_lat, gk_all, gv))
    if not with_ctx_out:
        return None, y_lat
    y_ctx = merge(diff_attention(q[:, :, :n_ctx], k[:, :, :n_ctx], v[:, :, :n_ctx], lam, lp['subln'], lambda_init),
                  pool_mixer(pool_in[:, :n_ctx], lp['w_pool'], lp['pool_scale']),
                  gqa_attention(gq[:, :, :n_ctx], gk[:, :, :n_ctx], gv[:, :, :n_ctx]))
    return y_ctx, y_lat


def conv_ffn(h, w_up, conv_w, conv_b, w_down):
    t = h.shape[1]
    u = h @ w_up
    pad = CONV_W // 2
    up = jnp.pad(u, ((0, 0), (pad, CONV_W - 1 - pad), (0, 0)))
    u = sum(up[:, j:j + t] * conv_w[j] for j in range(CONV_W)) + conv_b
    gate, val = jnp.split(u, 2, axis=-1)
    return (jax.nn.silu(gate) * val) @ w_down


def setup_inputs(seed: int = 0) -> dict:
    key = jax.random.key(seed)
    ks = jax.random.split(key, 25)
    f32 = jnp.float32

    def nrm(k, shape, scale):
        return jax.random.normal(k, shape, f32) * scale

    def gain(k, shape):
        return 1.0 + 0.05 * jax.random.normal(k, shape, f32)

    return {
        'x': nrm(ks[0], (BATCH, SEQ, D_MODEL), 1.0),
        'c': nrm(ks[1], (BATCH, D_MODEL), 1.0),
        'ctx': nrm(ks[2], (BATCH, CTX_LEN, D_MODEL), 1.0),
        'c_ctx': nrm(ks[3], (D_MODEL,), 1.0),
        'w_mod': nrm(ks[4], (DEPTH, D_MODEL, N_MOD * D_MODEL), 0.5 * D_MODEL ** -0.5),
        'b_mod': nrm(ks[5], (DEPTH, N_MOD * D_MODEL), 0.01),
        'norm_mix': gain(ks[6], (DEPTH, D_MODEL)),
        'norm_ffn': gain(ks[7], (DEPTH, D_MODEL)),
        'w_in': nrm(ks[8], (DEPTH, D_MODEL, IN_COLS), D_MODEL ** -0.5),
        'da_lambda_q1': nrm(ks[9], (DEPTH, DA_HALF_DIM), 0.1),
        'da_lambda_k1': nrm(ks[10], (DEPTH, DA_HALF_DIM), 0.1),
        'da_lambda_q2': nrm(ks[11], (DEPTH, DA_HALF_DIM), 0.1),
        'da_lambda_k2': nrm(ks[12], (DEPTH, DA_HALF_DIM), 0.1),
        'da_subln': gain(ks[13], (DEPTH, DA_V_DIM)),
        'gqa_q_norm': gain(ks[14], (DEPTH, GQA_HEAD_DIM)),
        'gqa_k_norm': gain(ks[15], (DEPTH, GQA_HEAD_DIM)),
        'pool_w': nrm(ks[16], (DEPTH, len(POOL_WINDOWS), POOL_GROUP_DIM, POOL_GROUP_DIM), POOL_GROUP_DIM ** -0.5),
        'pool_scale': gain(ks[17], (DEPTH, POOL_WIDTH)),
        'gqa_out_norm': gain(ks[18], (DEPTH, GQA_WIDTH)),
        'w_out': nrm(ks[19], (DEPTH, MIX_WIDTH, D_MODEL), MIX_WIDTH ** -0.5),
        'w_up': nrm(ks[20], (DEPTH, D_MODEL, 2 * D_FF), D_MODEL ** -0.5),
        'conv_w': nrm(ks[21], (DEPTH, CONV_W, 2 * D_FF), CONV_W ** -0.5),
        'conv_b': nrm(ks[22], (DEPTH, 2 * D_FF), 0.01),
        'w_down': nrm(ks[23], (DEPTH, D_FF, D_MODEL), D_FF ** -0.5),
        'final_norm': gain(ks[24], (D_MODEL,)),
    }


def reference(x, c, ctx, c_ctx, w_mod, b_mod, norm_mix, norm_ffn, w_in,
              da_lambda_q1, da_lambda_k1, da_lambda_q2, da_lambda_k2, da_subln,
              gqa_q_norm, gqa_k_norm, pool_w, pool_scale, gqa_out_norm, w_out,
              w_up, conv_w, conv_b, w_down, final_norm):
    n_lat = x.shape[1]
    ROWS = n_lat // GRID_W
    row = jnp.repeat(jnp.arange(ROWS, dtype=jnp.float32), GRID_W)
    col = jnp.tile(jnp.arange(GRID_W, dtype=jnp.float32), ROWS)
    ang_da = axial_angles(row, col, DA_HALF_DIM)
    ang_gqa = axial_angles(row, col, GQA_HEAD_DIM)
    silu_c = jax.nn.silu(c)
    silu_c_ctx = jax.nn.silu(c_ctx)

    for l in range(DEPTH):
        last = l == DEPTH - 1
        lambda_init = 0.8 - 0.6 * math.exp(-0.3 * l)
        mod_lat = (silu_c @ w_mod[l] + b_mod[l])[:, None, :]
        mod_ctx = (silu_c_ctx @ w_mod[l] + b_mod[l])[None, None, :]
        sh1, sc1, g1, sh2, sc2, g2 = jnp.split(mod_lat, N_MOD, axis=-1)
        csh1, csc1, cg1, csh2, csc2, cg2 = jnp.split(mod_ctx, N_MOD, axis=-1)
        lp = dict(w_in=w_in[l], w_out=w_out[l], lq1=da_lambda_q1[l], lk1=da_lambda_k1[l],
                  lq2=da_lambda_q2[l], lk2=da_lambda_k2[l], subln=da_subln[l],
                  q_norm=gqa_q_norm[l], k_norm=gqa_k_norm[l], w_pool=pool_w[l],
                  pool_scale=pool_scale[l], gqa_out_norm=gqa_out_norm[l])

        h_lat = modulate(x, norm_mix[l], sh1, sc1)
        h_ctx = modulate(ctx, norm_mix[l], csh1, csc1)
        y_ctx, y_lat = token_mixer(h_ctx, h_lat, ang_da, ang_gqa, lp, lambda_init, not last)
        x = x + g1 * y_lat
        x = x + g2 * conv_ffn(modulate(x, norm_ffn[l], sh2, sc2), w_up[l], conv_w[l], conv_b[l], w_down[l])
        if not last:
            ctx = ctx + cg1 * y_ctx
            ctx = ctx + cg2 * conv_ffn(modulate(ctx, norm_ffn[l], csh2, csc2), w_up[l], conv_w[l], conv_b[l], w_down[l])

    return rms_norm(x, final_norm)
```

```cpp
#include <hip/hip_runtime.h>
#include <hip/hip_cooperative_groups.h>
#include <cstdio>
#include <cstdint>
namespace cg = cooperative_groups;

#define LAS __attribute__((address_space(3)))
typedef unsigned short bf16_t;
typedef short bf16x8 __attribute__((ext_vector_type(8)));
typedef short s16x4 __attribute__((ext_vector_type(4)));
typedef float f32x2 __attribute__((ext_vector_type(2)));
typedef float f32x4 __attribute__((ext_vector_type(4)));
typedef float f32x16 __attribute__((ext_vector_type(16)));
typedef unsigned u32x2 __attribute__((ext_vector_type(2)));
typedef unsigned u32x4 __attribute__((ext_vector_type(4)));

constexpr int NB = 4, SEQ = 2048, CTX = 256, TOK = SEQ + CTX  , MROWS = NB * TOK  ;
constexpr int DM = 2048, INC = 4096, MIXW = 2048, DFF = 5632, DFF2 = 11264, NMOD6 = 6 * DM  ;
constexpr int C_DAQ = 0, C_DAK = 768, C_DAV = 1536, C_POOL = 2304, C_GQ = 2816, C_GK = 3584, C_GV = 3840;
constexpr float EPS = 1e-6f;

constexpr size_t MiB = 1u << 20;
constexpr size_t WS_MOD = 0;
constexpr size_t WS_CTL = 512 * 1024, CTL_BYTES = 16384;
constexpr size_t WS_WPOOL = 1 * MiB;
constexpr size_t WS_WIN = 2 * MiB;
constexpr size_t WS_WOUT = WS_WIN + 32 * MiB;
constexpr size_t WS_WUP = WS_WOUT + 16 * MiB;
constexpr size_t WS_WDN = WS_WUP + 88 * MiB;
constexpr size_t WS_X = WS_WDN + 44 * MiB;
constexpr size_t WS_H = WS_X + 72 * MiB;
constexpr size_t WS_ACT = WS_H + 36 * MiB;
constexpr size_t WS_U = WS_ACT + 99 * MiB;
constexpr size_t WS_PROJ = WS_U;
constexpr size_t WS_AO = WS_PROJ + 72 * MiB;
constexpr size_t WS_MRG = WS_AO + 81 * MiB;
constexpr size_t WS_PART = WS_U + 198 * MiB;
constexpr size_t WS_END = WS_PART + 64 * MiB;
static_assert(WS_MRG + 36 * MiB <= WS_PART, "overlay");

typedef __bf16 bf16x2_t __attribute__((ext_vector_type(2)));
__device__ __forceinline__ unsigned cvt_pk_bf16(float lo, float hi) { f32x2 v = {lo, hi}; bf16x2_t b = __builtin_convertvector(v, bf16x2_t); return __builtin_bit_cast(unsigned, b); }
__device__ __forceinline__ float bflo(unsigned w) { return __uint_as_float(w << 16); }
__device__ __forceinline__ float bfhi(unsigned w) { return __uint_as_float(w & 0xffff0000u); }
__device__ __forceinline__ float wave_sum(float v) {
#pragma unroll
    for (int o = 1; o < 64; o <<= 1) v += __shfl_xor(v, o);
    return v;
}
__device__ __forceinline__ float silu_f(float v) { return v * __builtin_amdgcn_rcpf(1.f + __expf(-v)); }

namespace pg8 {
constexpr int BM = 256, BK = 64, HALF = 128, HTB = HALF * BK * 2, STAGE_BYTES = 8 * HTB, NXCD = 8, WGM = 8;
__host__ __device__ __forceinline__ int lds_byte(int r, int c) { const int st = (r >> 4) * 2 + (c >> 5), rr = r & 15, cc = c & 31, ob = rr * 64 + cc * 2; return st * 1024 + (ob ^ (((ob >> 9) & 1) << 5)); }
__host__ __device__ __forceinline__ void stage_rc(int b, int& R, int& C) { const int st = b / 1024, sb = b % 1024, swz = sb ^ (((sb >> 9) & 1) << 5); R = (st >> 1) * 16 + swz / 64; C = (st & 1) * 32 + (swz % 64) / 2; }
__host__ __device__ __forceinline__ int perm32(int rho) { const int n = rho >> 4, i = rho & 15; return 8 * (i >> 2) + 4 * n + (i & 3); }

struct Unit { int pm, pn, kt0, ktn, atomic, ks; };
struct Gemm { const bf16_t* A; const bf16_t* Bt; int M, N, K; };

struct StaticOrder {
    int nM, nN, nwg, G, c, skip;
    int nt, splitctx;
    __device__ __forceinline__ void init(int nM_, int nN_, int G_, int c_, int skip_, int nt_, int splitctx_ = 0) { nM = nM_; nN = nN_; nwg = nM * nN; G = G_; c = c_; skip = skip_; nt = nt_; splitctx = splitctx_; }
    __device__ __forceinline__ bool next(int i, Unit& u) const {
        u.kt0 = 0; u.ktn = nt; u.atomic = 0; u.ks = 0;
        if (splitctx) {
            if (i == 0) { const int rt = (c & 7) * 4 + (c >> 6); u.pm = (rt >> 3) * 9 + 1 + (rt & 7); u.pn = (c >> 3) & 7; return true; }
            if (i == 1) { const int cu = c >> 3, ks = c & 7; u.pm = (cu >> 3) * 9; u.pn = cu & 7; u.atomic = 1; u.ks = ks;
                if (nt == 32) { u.kt0 = 4 * ks; u.ktn = 4; } else { u.kt0 = 11 * ks + (ks & 1); u.ktn = (ks & 1) ? 10 : 12; }
                return true; }
            return false;
        }
        const long L = (long)i * G + c; if (L >= nwg) return false;
        int wgid = (int)L; { const int q = nwg / NXCD, r = nwg % NXCD, xcd = wgid % NXCD, off = wgid / NXCD; wgid = (xcd < r ? xcd * (q + 1) : r * (q + 1) + (xcd - r) * q) + off; }
        const int nig = WGM * nN, gid = wgid / nig, fm = gid * WGM, gsz = (nM - fm) < WGM ? (nM - fm) : WGM;
        int pm = fm + ((wgid % nig) % gsz); u.pn = (wgid % nig) / gsz;
        if (skip) pm = (pm >> 3) * 9 + 1 + (pm & 7);
        u.pm = pm; return true;
    }
    __device__ __forceinline__ void a_ready(const Unit&) const {}
    __device__ __forceinline__ void done(const Unit&) const {}
};

struct EpiBf16 {
    static constexpr bool PERM = true, AFTER_DRAIN = false;
    bf16_t* O; int ldc;
    __device__ __forceinline__ void operator()(const f32x4 (&acc)[2][2][4][2], const Unit& u, int wr, int wc, int fr, int fq) const {
        const int row0 = u.pm * BM + wr * 64 + fr; const int col0 = u.pn * BM + wc * 32 + 8 * fq;
#pragma unroll
        for (int ai = 0; ai < 2; ++ai)
#pragma unroll
            for (int m = 0; m < 4; ++m) { bf16_t* rowp = O + (size_t)(row0 + ai * HALF + m * 16) * ldc + col0;
#pragma unroll
                for (int bj = 0; bj < 2; ++bj) { const f32x4 v0 = acc[ai][bj][m][0], v1 = acc[ai][bj][m][1];
                    u32x4 w; w.x = cvt_pk_bf16(v0[0], v0[1]); w.y = cvt_pk_bf16(v0[2], v0[3]); w.z = cvt_pk_bf16(v1[0], v1[1]); w.w = cvt_pk_bf16(v1[2], v1[3]);
                    *(u32x4*)(rowp + bj * HALF) = w; } }
    }
};
struct EpiConvAct {
    static constexpr bool PERM = true, AFTER_DRAIN = false;
    bf16_t* ACT; bf16_t* EDGE; const float* cw; const float* cb; LAS float* xch;
    __device__ __forceinline__ void operator()(f32x4 (&acc)[2][2][4][2], const Unit& u, int wr, int wc, int fr_, int fq_) const {
        int fr = fr_, fq = fq_; asm volatile("" : "+v"(fr), "+v"(fq));
        const int jc = 32 * wc + 8 * fq, gcol = u.pn * 128 + jc;
        f32x4 Wc[2][4];
#define EPI_LOADW(buf, g) do { const int col_ = ((g) >> 1) * DFF + gcol + 4 * ((g) & 1); Wc[buf][0] = *(const f32x4*)(cw + col_); Wc[buf][1] = *(const f32x4*)(cw + DFF2 + col_); \
            Wc[buf][2] = *(const f32x4*)(cw + 2 * DFF2 + col_); Wc[buf][3] = *(const f32x4*)(cb + col_); } while (0)
        EPI_LOADW(0, 0);
        if (wr == 0 && fr < 2) { bf16_t* e = EDGE + (size_t)(u.pm * 4 + fr) * DFF2 + gcol;
#pragma unroll
            for (int bj = 0; bj < 2; ++bj) { const f32x4 a = acc[0][bj][0][0], b = acc[0][bj][0][1]; u32x4 w; w.x = cvt_pk_bf16(a[0], a[1]); w.y = cvt_pk_bf16(a[2], a[3]); w.z = cvt_pk_bf16(b[0], b[1]); w.w = cvt_pk_bf16(b[2], b[3]); *(u32x4*)(e + bj * DFF) = w; } }
        if (wr == 1 && fr >= 14) { bf16_t* e = EDGE + (size_t)(u.pm * 4 + 2 + (fr - 14)) * DFF2 + gcol;
#pragma unroll
            for (int bj = 0; bj < 2; ++bj) { const f32x4 a = acc[1][bj][3][0], b = acc[1][bj][3][1]; u32x4 w; w.x = cvt_pk_bf16(a[0], a[1]); w.y = cvt_pk_bf16(a[2], a[3]); w.z = cvt_pk_bf16(b[0], b[1]); w.w = cvt_pk_bf16(b[2], b[3]); *(u32x4*)(e + bj * DFF) = w; } }
#pragma unroll
        for (int ai = 0; ai < 2; ++ai) { const int q = ai * 2 + wr;
#pragma unroll
            for (int bj = 0; bj < 2; ++bj)
#pragma unroll
                for (int n = 0; n < 2; ++n) {
                    if (fr == 0)  *(LAS f32x4*)(xch + ((q * 2 + 0) * 2 + bj) * 128 + jc + 4 * n) = acc[ai][bj][0][n];
                    if (fr == 15) *(LAS f32x4*)(xch + ((q * 2 + 1) * 2 + bj) * 128 + jc + 4 * n) = acc[ai][bj][3][n]; } }
        asm volatile("s_waitcnt lgkmcnt(0)" ::: "memory"); __builtin_amdgcn_s_barrier(); asm volatile("" ::: "memory");
#pragma unroll
        for (int g = 0; g < 4; ++g) { const int bj = g >> 1, n = g & 1;
            if (g == 0) EPI_LOADW(1, 1); else if (g == 1) EPI_LOADW(0, 2); else if (g == 2) EPI_LOADW(1, 3);
            const f32x4 w0 = Wc[g & 1][0], w1 = Wc[g & 1][1], w2 = Wc[g & 1][2], bb = Wc[g & 1][3];
#pragma unroll
            for (int ai = 0; ai < 2; ++ai) { const int q = ai * 2 + wr;
                    const int qu = q > 0 ? q - 1 : 0, qd = q < 3 ? q + 1 : 3;
                    f32x4 bup = *(const LAS f32x4*)(xch + ((qu * 2 + 1) * 2 + bj) * 128 + jc + 4 * n), bdn = *(const LAS f32x4*)(xch + ((qd * 2 + 0) * 2 + bj) * 128 + jc + 4 * n);
                    const float mu = q > 0 ? 1.f : 0.f, md = q < 3 ? 1.f : 0.f; bup = bup * mu; bdn = bdn * md;
                    f32x4 R[4], O[4];
#pragma unroll
                    for (int m = 0; m < 4; ++m) R[m] = acc[ai][bj][m][n];
#pragma unroll
                    for (int m = 0; m < 4; ++m) { const f32x4 pv = m > 0 ? R[m - 1] : bup, nx = m < 3 ? R[m + 1] : bdn; f32x4 up, dn;
#pragma unroll
                        for (int e = 0; e < 4; ++e) {
                            up[e] = __builtin_bit_cast(float, __builtin_amdgcn_mov_dpp(__builtin_bit_cast(int, fr == 15 ? pv[e] : R[m][e]), 0x121  , 0xf, 0xf, false));
                            dn[e] = __builtin_bit_cast(float, __builtin_amdgcn_mov_dpp(__builtin_bit_cast(int, fr == 0 ? nx[e] : R[m][e]), 0x12f  , 0xf, 0xf, false)); }
                        O[m] = __builtin_elementwise_fma(w0, up, __builtin_elementwise_fma(w1, R[m], __builtin_elementwise_fma(w2, dn, bb))); }
#pragma unroll
                    for (int m = 0; m < 4; ++m) acc[ai][bj][m][n] = O[m];
            }
            asm volatile("" ::: "memory"); }
#undef EPI_LOADW
#pragma unroll
        for (int ai = 0; ai < 2; ++ai)
#pragma unroll
            for (int m = 0; m < 4; ++m) { const f32x4 g0 = acc[ai][0][m][0], g1 = acc[ai][0][m][1], v0 = acc[ai][1][m][0], v1 = acc[ai][1][m][1];
                u32x4 w; w.x = cvt_pk_bf16(silu_f(g0[0]) * v0[0], silu_f(g0[1]) * v0[1]); w.y = cvt_pk_bf16(silu_f(g0[2]) * v0[2], silu_f(g0[3]) * v0[3]);
                w.z = cvt_pk_bf16(silu_f(g1[0]) * v1[0], silu_f(g1[1]) * v1[1]); w.w = cvt_pk_bf16(silu_f(g1[2]) * v1[2], silu_f(g1[3]) * v1[3]);
                *(u32x4*)(ACT + (size_t)(u.pm * BM + ai * HALF + wr * 64 + m * 16 + fr) * DFF + gcol) = w; }
    }
};
struct EpiResid {
    static constexpr bool PERM = false, AFTER_DRAIN = false;
    float* X; const float* gate; float* part; const float* xin_lat; const float* xin_ctx;
    __device__ __forceinline__ void operator()(const f32x4 (&acc)[2][2][4][2], const Unit& u, int wr, int wc, int fr_, int fq_) const {
        int fr = fr_, fq = fq_; asm volatile("" : "+v"(fr), "+v"(fq));
        const int bb = u.pm / 9, r = (u.pm - bb * 9 == 0) ? 4 : bb;
        const int col0 = u.pn * BM + wc * 32 + 4 * fq;
        const float* g = gate + (size_t)r * NMOD6 + col0;
        f32x4 gv[2][2];
#pragma unroll
        for (int bj = 0; bj < 2; ++bj)
#pragma unroll
            for (int n = 0; n < 2; ++n) gv[bj][n] = *(const f32x4*)(g + bj * HALF + n * 16);
        if (u.atomic) {
#pragma unroll
            for (int ai = 0; ai < 2; ++ai)
#pragma unroll
                for (int m = 0; m < 4; ++m)
#pragma unroll
                    for (int bj = 0; bj < 2; ++bj)
#pragma unroll
                        for (int n = 0; n < 2; ++n) *(f32x4*)(part + ((size_t)(u.ks * 1024 + bb * 256 + ai * HALF + wr * 64 + m * 16 + fr)) * DM + col0 + bj * HALF + n * 16) = acc[ai][bj][m][n];
            return;
        }
        const int jt = u.pm - bb * 9;
#pragma unroll
        for (int ai = 0; ai < 2; ++ai) {
            f32x4 xv[4][2][2];
#pragma unroll
            for (int m = 0; m < 4; ++m) { const int rr = ai * HALF + wr * 64 + m * 16 + fr;
                const float* xs = X + (size_t)(u.pm * BM + rr) * DM + col0;
                if (jt == 0) { if (xin_ctx) xs = xin_ctx + ((size_t)bb * CTX + rr) * DM + col0; } else { if (xin_lat) xs = xin_lat + ((size_t)bb * SEQ + (jt - 1) * 256 + rr) * DM + col0; }
#pragma unroll
                for (int bj = 0; bj < 2; ++bj)
#pragma unroll
                    for (int n = 0; n < 2; ++n) xv[m][bj][n] = *(const f32x4*)(xs + bj * HALF + n * 16); }
            asm volatile("" ::: "memory");
#pragma unroll
            for (int m = 0; m < 4; ++m) { float* xp = X + (size_t)(u.pm * BM + ai * HALF + wr * 64 + m * 16 + fr) * DM + col0;
#pragma unroll
                for (int bj = 0; bj < 2; ++bj)
#pragma unroll
                    for (int n = 0; n < 2; ++n) *(f32x4*)(xp + bj * HALF + n * 16) = xv[m][bj][n] + gv[bj][n] * acc[ai][bj][m][n]; }
            asm volatile("" ::: "memory");
        }
    }
};

template <class Epi, class Sched, bool ALIGN_EPI = false, bool SP2 = false>
__device__ __forceinline__ void gemm_phase(LAS unsigned char* lds, const Gemm g, const Sched& S, const Epi& E, const int tid) {
    const int wid = __builtin_amdgcn_readfirstlane(tid >> 6), lane = tid & 63, wr = wid >> 2, wc = wid & 3, fr = lane & 15, fq = lane >> 4;
    const int K = g.K;
    unsigned voffA[2], voffB[2];
#pragma unroll
    for (int i = 0; i < 2; ++i) { int R, C; stage_rc(tid * 16 + i * 8192, R, C); const int Rb = Epi::PERM ? ((R & ~31) + perm32(R & 31)) : R;
        voffA[i] = (unsigned)(R * K + C) * 2u; voffB[i] = (unsigned)(Rb * K + C) * 2u; }
    const size_t kstep = (size_t)(BK * 2);
    const size_t hstep = (size_t)HALF * K * 2;
    const size_t tstep = 2 * hstep;
    const unsigned ldsw = (unsigned)wid * 1024u;
    const int aoff = lds_byte(wr * 64 + fr, fq * 8), boff = lds_byte(wc * 32 + fr, fq * 8);
#define PG8_SA(b, h) (((b) * 2 + (h)) * HTB)
#define PG8_SB(b, h) ((4 + (b) * 2 + (h)) * HTB)
#define PG8_STAGE(bufoff, gbase, voff) do { _Pragma("unroll") for (int _i = 0; _i < 2; ++_i) \
        __builtin_amdgcn_global_load_lds((const unsigned*)((const char*)(gbase) + (voff)[_i]), (LAS unsigned*)(lds + (bufoff) + ldsw + _i * 8192), 16, 0, 0); } while (0)
#define PG8_LDA(dst, b, h) do { _Pragma("unroll") for (int m = 0; m < 4; ++m) _Pragma("unroll") for (int k = 0; k < 2; ++k) dst[m][k] = *(const LAS bf16x8*)(lds + PG8_SA(b, h) + aoff + m * 2048 + k * 1024); } while (0)
#define PG8_LDB(dst, b, h) do { _Pragma("unroll") for (int n = 0; n < 2; ++n) _Pragma("unroll") for (int k = 0; k < 2; ++k) dst[n][k] = *(const LAS bf16x8*)(lds + PG8_SB(b, h) + boff + n * 2048 + k * 1024); } while (0)
#define PG8_MMA(ai, bj, At, Bt) do { __builtin_amdgcn_s_setprio(1); _Pragma("unroll") for (int m = 0; m < 4; ++m) _Pragma("unroll") for (int n = 0; n < 2; ++n) _Pragma("unroll") for (int k = 0; k < 2; ++k) \
        acc[ai][bj][m][n] = __builtin_amdgcn_mfma_f32_16x16x32_bf16(Bt[n][k], At[m][k], acc[ai][bj][m][n], 0, 0, 0); __builtin_amdgcn_s_setprio(0); } while (0)
#define PG8_WAIT_V(n) asm volatile("s_waitcnt vmcnt(" #n ")" ::: "memory")
#define PG8_WAIT_L(n) asm volatile("s_waitcnt lgkmcnt(" #n ")" ::: "memory")
#define PG8_BAR __builtin_amdgcn_s_barrier()
#define PG8_SCHED __builtin_amdgcn_sched_barrier(0)
    Unit cur, nxt; int ui = 0;
    if (!S.next(0, cur)) return;
    f32x4 acc[2][2][4][2];
#pragma unroll
    for (int a = 0; a < 2; ++a)
#pragma unroll
        for (int b = 0; b < 2; ++b)
#pragma unroll
            for (int m = 0; m < 4; ++m)
#pragma unroll
                for (int n = 0; n < 2; ++n) acc[a][b][m][n] = (f32x4){0.f, 0.f, 0.f, 0.f};
    bf16x8 At[4][2], B0[2][2], B1[2][2];
    const char* cA = (const char*)g.A + (size_t)cur.pm * tstep + (size_t)cur.kt0 * kstep; const char* cB = (const char*)g.Bt + (size_t)cur.pn * tstep + (size_t)cur.kt0 * kstep;
    S.a_ready(cur);
    if constexpr (SP2) {
        PG8_STAGE(PG8_SB(0, 0), cB, voffB); PG8_STAGE(PG8_SB(0, 1), cB + hstep, voffB); PG8_STAGE(PG8_SA(0, 0), cA, voffA); PG8_STAGE(PG8_SA(0, 1), cA + hstep, voffA);
        if (wr == 1) PG8_BAR;
        PG8_WAIT_V(2); PG8_BAR;
        PG8_STAGE(PG8_SB(1, 0), cB + kstep, voffB); PG8_STAGE(PG8_SA(1, 0), cA + kstep, voffA); PG8_STAGE(PG8_SB(1, 1), cB + hstep + kstep, voffB);
        PG8_WAIT_V(6); PG8_BAR;
    } else {
        PG8_STAGE(PG8_SB(0, 0), cB, voffB); PG8_STAGE(PG8_SA(0, 0), cA, voffA); PG8_STAGE(PG8_SB(0, 1), cB + hstep, voffB); PG8_STAGE(PG8_SA(0, 1), cA + hstep, voffA);
        if (wr == 1) PG8_BAR;
        PG8_WAIT_V(4); PG8_BAR;
        PG8_STAGE(PG8_SB(1, 0), cB + kstep, voffB); PG8_STAGE(PG8_SA(1, 0), cA + kstep, voffA); PG8_STAGE(PG8_SB(1, 1), cB + hstep + kstep, voffB);
        PG8_WAIT_V(6); PG8_BAR;
    }
    for (;;) {
        const bool has_next = S.next(ui + 1, nxt);
        const char* nA = has_next ? (const char*)g.A + (size_t)nxt.pm * tstep + (size_t)nxt.kt0 * kstep : cA; const char* nB = has_next ? (const char*)g.Bt + (size_t)nxt.pn * tstep + (size_t)nxt.kt0 * kstep : cB;
        const int nt = cur.ktn;
        for (int t = 0; t < nt; t += 2) {
            const bool last = (t == nt - 2);
            const char* a1 = cA + (size_t)(t + 1) * kstep;
            const char* a2 = last ? nA : cA + (size_t)(t + 2) * kstep; const char* b2 = last ? nB : cB + (size_t)(t + 2) * kstep;
            const char* a3 = a2 + kstep; const char* b3 = b2 + kstep;
            if (last && has_next) S.a_ready(nxt);
            if constexpr (SP2) {
            PG8_LDB(B0, 0, 0); PG8_LDB(B1, 0, 1); PG8_SCHED; PG8_LDA(At, 0, 0); PG8_STAGE(PG8_SA(1, 1), a1 + hstep, voffA);
            PG8_WAIT_V(8); PG8_WAIT_L(0); PG8_BAR; PG8_MMA(0, 0, At, B0); PG8_MMA(0, 1, At, B1); PG8_BAR; PG8_SCHED;
            PG8_LDA(At, 0, 1); PG8_STAGE(PG8_SB(0, 0), b2, voffB); PG8_STAGE(PG8_SB(0, 1), b2 + hstep, voffB); PG8_STAGE(PG8_SA(0, 0), a2, voffA);
            PG8_WAIT_V(8); PG8_WAIT_L(0); PG8_BAR; PG8_MMA(1, 0, At, B0); PG8_MMA(1, 1, At, B1); PG8_BAR; PG8_SCHED;
            PG8_LDB(B0, 1, 0); PG8_LDB(B1, 1, 1); PG8_SCHED; PG8_LDA(At, 1, 0); PG8_STAGE(PG8_SA(0, 1), a2 + hstep, voffA);
            PG8_WAIT_V(8); PG8_WAIT_L(0); PG8_BAR; PG8_MMA(0, 0, At, B0); PG8_MMA(0, 1, At, B1); PG8_BAR; PG8_SCHED;
            PG8_LDA(At, 1, 1); PG8_STAGE(PG8_SB(1, 0), b3, voffB); PG8_STAGE(PG8_SB(1, 1), b3 + hstep, voffB); PG8_STAGE(PG8_SA(1, 0), a3, voffA);
            PG8_WAIT_V(8); PG8_WAIT_L(0); PG8_BAR; PG8_MMA(1, 0, At, B0); PG8_MMA(1, 1, At, B1); PG8_BAR; PG8_SCHED;
            } else {
            PG8_LDB(B0, 0, 0); PG8_SCHED; PG8_LDA(At, 0, 0); PG8_STAGE(PG8_SA(1, 1), a1 + hstep, voffA);
            PG8_WAIT_L(8); PG8_BAR; PG8_WAIT_L(0); PG8_MMA(0, 0, At, B0); PG8_BAR; PG8_SCHED;
            PG8_LDB(B1, 0, 1); PG8_STAGE(PG8_SB(0, 0), b2, voffB);
            PG8_BAR; PG8_WAIT_L(0); PG8_MMA(0, 1, At, B1); PG8_BAR;
            PG8_LDA(At, 0, 1); PG8_STAGE(PG8_SA(0, 0), a2, voffA);
            PG8_BAR; PG8_WAIT_L(0); PG8_MMA(1, 0, At, B0); PG8_BAR; PG8_SCHED;
            PG8_STAGE(PG8_SB(0, 1), b2 + hstep, voffB);
            PG8_WAIT_V(6); PG8_BAR; PG8_MMA(1, 1, At, B1); PG8_BAR;
            PG8_LDB(B0, 1, 0); PG8_SCHED; PG8_LDA(At, 1, 0); PG8_STAGE(PG8_SA(0, 1), a2 + hstep, voffA);
            PG8_WAIT_L(8); PG8_BAR; PG8_WAIT_L(0); PG8_MMA(0, 0, At, B0); PG8_BAR; PG8_SCHED;
            PG8_LDB(B1, 1, 1); PG8_STAGE(PG8_SB(1, 0), b3, voffB);
            PG8_BAR; PG8_WAIT_L(0); PG8_MMA(0, 1, At, B1); PG8_BAR;
            PG8_LDA(At, 1, 1); PG8_STAGE(PG8_SA(1, 0), a3, voffA);
            PG8_BAR; PG8_WAIT_L(0); PG8_MMA(1, 0, At, B0); PG8_BAR; PG8_SCHED;
            PG8_STAGE(PG8_SB(1, 1), b3 + hstep, voffB);
            PG8_WAIT_V(6); PG8_BAR; PG8_MMA(1, 1, At, B1); PG8_BAR;
            }
        }
        if constexpr (ALIGN_EPI) { if (wr == 0) PG8_BAR; }
        if constexpr (!Epi::AFTER_DRAIN) { E(acc, cur, wr, wc, fr, fq); S.done(cur); }
        if (!has_next) break;
#pragma unroll
        for (int a = 0; a < 2; ++a)
#pragma unroll
            for (int b = 0; b < 2; ++b)
#pragma unroll
                for (int m = 0; m < 4; ++m)
#pragma unroll
                    for (int n = 0; n < 2; ++n) acc[a][b][m][n] = (f32x4){0.f, 0.f, 0.f, 0.f};
        cur = nxt; cA = nA; cB = nB; ++ui;
        if constexpr (ALIGN_EPI) { if (wr == 1) PG8_BAR; }
    }
    PG8_WAIT_V(0);
    if constexpr (!ALIGN_EPI) { if (wr == 0) PG8_BAR; }
    PG8_BAR;
#undef PG8_SA
#undef PG8_SB
#undef PG8_STAGE
#undef PG8_LDA
#undef PG8_LDB
#undef PG8_MMA
#undef PG8_WAIT_V
#undef PG8_WAIT_L
#undef PG8_BAR
#undef PG8_SCHED
}
}

namespace att {
constexpr int NW = 8, QBLK = 32, KVBLK = 64, LDP = INC  , LDO = 768;
constexpr float THR = 8.f;
constexpr int SHM_V = KVBLK * 128 * 2;
#define SBAR() __builtin_amdgcn_sched_barrier(0)
__device__ __forceinline__ int crow(int r, int hi) { return (r & 3) + 8 * (r >> 2) + 4 * hi; }
template <int DK> __device__ __forceinline__ int kswz(int row, int colB) { return row * (DK * 2) + (colB ^ ((row & 7) << 4)); }

template <int DK> __device__ __forceinline__ void partialSM(f32x16& p0, f32x16& p1, float& m_reg, float& mn, float& alpha) {
  constexpr float SCALE = (DK == 128) ? 0.088388347648318440f : 0.125f;
  constexpr float C = SCALE * 1.4426950408889634f;
  float pmax = p0[0];
#pragma unroll
  for (int r = 1; r < 16; ++r) pmax = fmaxf(pmax, p0[r]);
#pragma unroll
  for (int r = 0; r < 16; ++r) pmax = fmaxf(pmax, p1[r]);
  { auto rr = __builtin_amdgcn_permlane32_swap(__float_as_uint(pmax), __float_as_uint(pmax), false, false);
    pmax = fmaxf(__uint_as_float(rr[0]), __uint_as_float(rr[1])); }
  if (__builtin_expect(__all(pmax - m_reg <= THR / SCALE), 1)) { mn = m_reg; alpha = 1.f; }
  else { mn = fmaxf(m_reg, pmax); alpha = __builtin_amdgcn_exp2f((m_reg - mn) * C); m_reg = mn; }
  float mnC = -mn * C;
#pragma unroll
  for (int r = 0; r < 16; ++r) p0[r] = fmaf(p0[r], C, mnC);
#pragma unroll
  for (int r = 0; r < 16; ++r) p1[r] = fmaf(p1[r], C, mnC);
#pragma unroll
  for (int r = 0; r < 16; ++r) p0[r] = __builtin_amdgcn_exp2f(p0[r]);
}
__device__ __forceinline__ void finishSM(f32x16& p0, f32x16& p1, float alpha, float& l_reg, bf16x8& pa0, bf16x8& pa1, bf16x8& pa2, bf16x8& pa3) {
#pragma unroll
  for (int r = 0; r < 16; ++r) p1[r] = __builtin_amdgcn_exp2f(p1[r]);
  float ps = 0;
#pragma unroll
  for (int r = 0; r < 16; ++r) ps += p0[r];
#pragma unroll
  for (int r = 0; r < 16; ++r) ps += p1[r];
  { auto rr = __builtin_amdgcn_permlane32_swap(__float_as_uint(ps), __float_as_uint(ps), false, false);
    ps = __uint_as_float(rr[0]) + __uint_as_float(rr[1]); }
  l_reg = l_reg * alpha + ps;
#define PK4(P, BASE, OUT) do { unsigned a0 = cvt_pk_bf16(P[BASE + 0], P[BASE + 1]), a1 = cvt_pk_bf16(P[BASE + 2], P[BASE + 3]);   \
    unsigned b0 = cvt_pk_bf16(P[BASE + 4], P[BASE + 5]), b1 = cvt_pk_bf16(P[BASE + 6], P[BASE + 7]);                              \
    auto r0 = __builtin_amdgcn_permlane32_swap(a0, b0, false, false); auto r1 = __builtin_amdgcn_permlane32_swap(a1, b1, false, false); \
    u32x4 w = {r0[0], r1[0], r0[1], r1[1]}; OUT = *reinterpret_cast<bf16x8*>(&w); } while (0)
  PK4(p0, 0, pa0); PK4(p0, 8, pa1); PK4(p1, 0, pa2); PK4(p1, 8, pa3);
#undef PK4
}
template <int DK> __device__ __forceinline__ void qkt(f32x16& p0, f32x16& p1, const char* Ks, const bf16x8* qr, int r32, int hi) {
  p0 = f32x16{}; p1 = f32x16{};
#pragma unroll
  for (int d0 = 0; d0 < DK / 16; ++d0) { int cb = (d0 * 16 + hi * 8) * 2;
    bf16x8 b0 = *reinterpret_cast<const bf16x8*>(Ks + kswz<DK>(r32, cb));
    bf16x8 b1 = *reinterpret_cast<const bf16x8*>(Ks + kswz<DK>(32 + r32, cb));
    p0 = __builtin_amdgcn_mfma_f32_32x32x16_bf16(b0, qr[d0], p0, 0, 0, 0);
    p1 = __builtin_amdgcn_mfma_f32_32x32x16_bf16(b1, qr[d0], p1, 0, 0, 0); }
}
__device__ __forceinline__ int v_st(int k, int c) { const int kk = (k & ~0xC) | ((k & 4) << 1) | ((k & 8) >> 1); return ((kk >> 3) * 4 + (c >> 5)) * 512 + ((kk & 7) * 32 + (c & 31)) * 2; }
__device__ __forceinline__ int v_rd_base(int lane) { return ((lane & 3) << 3) | (((lane >> 2) & 3) << 6) | (((lane >> 4) & 1) << 5) | (((lane >> 5) & 1) << 8); }
constexpr int v_rd_off(int d0, int ks, int half) { return d0 * 512 + ks * 4096 + half * 2048; }
template <int OFF> __device__ __forceinline__ s16x4 tr_read(int vb) {
  s16x4 r; asm volatile("ds_read_b64_tr_b16 %0, %1 offset:%2" : "=&v"(r) : "v"(vb), "i"(OFF) : "memory"); return r;
}
template <int D0> __device__ __forceinline__ void pv_one(f32x16& od, int vb, bf16x8 pa0, bf16x8 pa1, bf16x8 pa2, bf16x8 pa3) {
  const s16x4 l0 = tr_read<v_rd_off(D0, 0, 0)>(vb), h0 = tr_read<v_rd_off(D0, 0, 1)>(vb), l1 = tr_read<v_rd_off(D0, 1, 0)>(vb), h1 = tr_read<v_rd_off(D0, 1, 1)>(vb);
  const s16x4 l2 = tr_read<v_rd_off(D0, 2, 0)>(vb), h2 = tr_read<v_rd_off(D0, 2, 1)>(vb), l3 = tr_read<v_rd_off(D0, 3, 0)>(vb), h3 = tr_read<v_rd_off(D0, 3, 1)>(vb);
  asm volatile("s_waitcnt lgkmcnt(0)" ::: "memory"); SBAR();
#define PK(L, H) (bf16x8){L[0], L[1], L[2], L[3], H[0], H[1], H[2], H[3]}
  od = __builtin_amdgcn_mfma_f32_32x32x16_bf16(pa0, PK(l0, h0), od, 0, 0, 0);
  od = __builtin_amdgcn_mfma_f32_32x32x16_bf16(pa1, PK(l1, h1), od, 0, 0, 0);
  od = __builtin_amdgcn_mfma_f32_32x32x16_bf16(pa2, PK(l2, h2), od, 0, 0, 0);
  od = __builtin_amdgcn_mfma_f32_32x32x16_bf16(pa3, PK(l3, h3), od, 0, 0, 0);
#undef PK
}
__device__ __forceinline__ void pv_d0(f32x16* o, int vb, bf16x8 pa0, bf16x8 pa1, bf16x8 pa2, bf16x8 pa3) {
  pv_one<0>(o[0], vb, pa0, pa1, pa2, pa3); pv_one<1>(o[1], vb, pa0, pa1, pa2, pa3); pv_one<2>(o[2], vb, pa0, pa1, pa2, pa3); pv_one<3>(o[3], vb, pa0, pa1, pa2, pa3);
}

template <int DK>
__device__ __forceinline__ void attn_unit(const bf16_t* __restrict__ Qb, const bf16_t* __restrict__ Kh, const bf16_t* __restrict__ Vh,
                                          float* __restrict__ Ob, int seq, char* lds, const int tid) {
  constexpr int SHM_K = KVBLK * DK * 2;
  const int wid = tid >> 6, lane = tid & 63, r32 = lane & 31, hi = lane >> 5;
  char* V_lds = lds; char* K_lds = lds + 2 * SHM_V;
  float* ws = (float*)(lds + 2 * SHM_V + 2 * SHM_K) + wid * 64; float* li_l = ws; float* al_l = ws + 32;
  float m_reg = -1e30f, l_reg = 0; f32x16 o[4] = {}; bf16x8 qr[DK / 16];
  const bf16_t* Qw = Qb + (long)(wid * QBLK + r32) * LDP + hi * 8;
#pragma unroll
  for (int d0 = 0; d0 < DK / 16; ++d0) qr[d0] = *reinterpret_cast<const bf16x8*>(Qw + d0 * 16);
  const int sr = tid >> 4, sc = (tid & 15) * 8, vst0 = v_st(sr, sc), vst1 = v_st(32 + sr, sc);
  const int ksr = (DK == 128) ? sr : (tid >> 3), ksc = (DK == 128) ? sc : ((tid & 7) * 8);
  const int vb0 = (int)(uintptr_t)V_lds + v_rd_base(lane);
  struct { bf16x8 vs0, vs1, ks0, ks1; } sr_[2];
#define SLOAD(i, k0) do { sr_[i].vs0 = *reinterpret_cast<const bf16x8*>(&Vh[(long)((k0) + sr) * LDP + sc]); sr_[i].vs1 = *reinterpret_cast<const bf16x8*>(&Vh[(long)((k0) + 32 + sr) * LDP + sc]); \
    sr_[i].ks0 = *reinterpret_cast<const bf16x8*>(&Kh[(long)((k0) + ksr) * LDP + ksc]); if constexpr (DK == 128) sr_[i].ks1 = *reinterpret_cast<const bf16x8*>(&Kh[(long)((k0) + 32 + ksr) * LDP + ksc]); } while (0)
#define SWRITE(b, i) do { *(bf16x8*)(V_lds + (b) * SHM_V + vst0) = sr_[i].vs0;          \
    *(bf16x8*)(V_lds + (b) * SHM_V + vst1) = sr_[i].vs1; int kc = ksc * 2;               \
    *(bf16x8*)(K_lds + (b) * SHM_K + kswz<DK>(ksr, kc)) = sr_[i].ks0;                       \
    if constexpr (DK == 128) *(bf16x8*)(K_lds + (b) * SHM_K + kswz<DK>(32 + ksr, kc)) = sr_[i].ks1; } while (0)
#define SWAIT() do { if constexpr (DK == 128) asm volatile("s_waitcnt vmcnt(4)" ::: "memory"); else asm volatile("s_waitcnt vmcnt(3)" ::: "memory"); } while (0)
#define RESC(a) do { if (__any((a) < 1.f)) { if (hi == 0) al_l[r32] = (a); asm volatile("s_waitcnt lgkmcnt(0)" ::: "memory"); \
    _Pragma("unroll") for (int d = 0; d < 4; ++d) _Pragma("unroll") for (int r = 0; r < 16; ++r) o[d][r] *= al_l[crow(r, hi)]; } } while (0)
  f32x16 pA0, pA1, pB0, pB1; float mnA, mnB, alA, alB; bf16x8 pa0, pa1, pa2, pa3; const int NT = seq / KVBLK;
  constexpr int SE = 0, SO = 1;
  SLOAD(SE, 0); asm volatile("s_waitcnt vmcnt(0)" ::: "memory"); SWRITE(0, SE); __syncthreads();
  qkt<DK>(pA0, pA1, K_lds, qr, r32, hi); partialSM<DK>(pA0, pA1, m_reg, mnA, alA);
  SLOAD(SO, KVBLK); if (2 < NT) SLOAD(SE, 2 * KVBLK);
  SWAIT(); SWRITE(1, SO); __syncthreads();
  for (int j = 1; j + 1 < NT; j += 2) {
    SBAR(); qkt<DK>(pB0, pB1, K_lds + SHM_K, qr, r32, hi);
    finishSM(pA0, pA1, alA, l_reg, pa0, pa1, pa2, pa3); SBAR();
    SLOAD(SO, (j + 2) * KVBLK); SBAR();
    pv_d0(o, vb0, pa0, pa1, pa2, pa3); partialSM<DK>(pB0, pB1, m_reg, mnB, alB);
    __syncthreads(); SWAIT(); SWRITE(0, SE);
    RESC(alB); __syncthreads();
    SBAR(); qkt<DK>(pA0, pA1, K_lds, qr, r32, hi);
    finishSM(pB0, pB1, alB, l_reg, pa0, pa1, pa2, pa3); SBAR();
    if (j + 3 < NT) SLOAD(SE, (j + 3) * KVBLK); SBAR();
    pv_d0(o, vb0 + (int)SHM_V, pa0, pa1, pa2, pa3); partialSM<DK>(pA0, pA1, m_reg, mnA, alA);
    __syncthreads(); SWAIT(); SWRITE(1, SO);
    RESC(alA); __syncthreads();
  }
  SBAR(); qkt<DK>(pB0, pB1, K_lds + SHM_K, qr, r32, hi);
  finishSM(pA0, pA1, alA, l_reg, pa0, pa1, pa2, pa3); SBAR();
  pv_d0(o, vb0, pa0, pa1, pa2, pa3); partialSM<DK>(pB0, pB1, m_reg, mnB, alB);
  __syncthreads(); RESC(alB);
  finishSM(pB0, pB1, alB, l_reg, pa0, pa1, pa2, pa3); SBAR();
  pv_d0(o, vb0 + (int)SHM_V, pa0, pa1, pa2, pa3);
  if (hi == 0) li_l[r32] = l_reg; asm volatile("s_waitcnt lgkmcnt(0)" ::: "memory");
  float rli[16];
#pragma unroll
  for (int r = 0; r < 16; ++r) rli[r] = __builtin_amdgcn_rcpf(li_l[crow(r, hi)]);
  float* Ow = Ob + (long)(wid * QBLK) * LDO;
#pragma unroll
  for (int r = 0; r < 16; ++r) { int orow = crow(r, hi);
#pragma unroll
    for (int d0 = 0; d0 < 4; ++d0) Ow[(long)orow * LDO + d0 * 32 + r32] = o[d0][r] * rli[r]; }
  __syncthreads();
#undef SLOAD
#undef SWRITE
#undef SWAIT
#undef RESC
}
}


#define XB_TMO      128
#define XB_XCNT(j)  (256  + 64 * (j))
#define XB_XSUB(j)  (1280 + 64 * (j))
#define XB_XGEN(j)  (2304 + 64 * (j))
#define XB_TOP      3328
#define XB_TOPGEN   3392
#define XCD_BAR_WORDS 3456
#define XB_SPIN_CAP (1u << 22)
__device__ __forceinline__ unsigned xb_ld(unsigned* p)              { return __hip_atomic_load(p, __ATOMIC_RELAXED, __HIP_MEMORY_SCOPE_AGENT); }
__device__ __forceinline__ unsigned xb_add(unsigned* p, unsigned v) { return __hip_atomic_fetch_add(p, v, __ATOMIC_RELAXED, __HIP_MEMORY_SCOPE_AGENT); }
__device__ __forceinline__ unsigned xb_xcc_id() { return (unsigned)__builtin_amdgcn_s_getreg((3 << 11) | 20) & 0xFu; }
#define XB_SPIN(cond, bar) do { unsigned _sp = 0; while (cond) { __builtin_amdgcn_s_sleep(1); \
    if ((++_sp & 255u) == 0u) { if (xb_ld(&(bar)[XB_TMO])) break; if (_sp > XB_SPIN_CAP) { atomicAdd(&(bar)[XB_TMO], 1u); break; } } } } while (0)
struct XcdBarrier { unsigned* bar; unsigned x; volatile LAS unsigned* st; };
__device__ __forceinline__ XcdBarrier xcd_barrier_post(unsigned* bar, volatile LAS unsigned* st) {
    XcdBarrier b; b.bar = bar; b.x = xb_xcc_id(); b.st = st;
    if (threadIdx.x == 0) (void)xb_add(&bar[XB_XCNT(b.x)], 1u);
    return b;
}
__device__ __forceinline__ void xcd_barrier_complete(unsigned* bar, unsigned x, unsigned& nloc, unsigned& nx) {
    const unsigned G = gridDim.x * gridDim.y * gridDim.z;
    unsigned sum, cnt, mine, sp = 0u;
    for (;;) {
        sum = 0u; cnt = 0u; mine = 0u;
#pragma unroll
        for (unsigned j = 0; j < 16; ++j) { const unsigned c = xb_ld(&bar[XB_XCNT(j)]); sum += c; cnt += (c > 0u) ? 1u : 0u; mine = (j == x) ? c : mine; }
        if (sum == G) break;
        __builtin_amdgcn_s_sleep(1);
        if ((++sp & 255u) == 0u) { if (xb_ld(&bar[XB_TMO])) break; if (sp > XB_SPIN_CAP) { atomicAdd(&bar[XB_TMO], 1u); break; } }
    }
    nloc = mine > 0u ? mine : 1u; nx = cnt > 0u ? cnt : 1u;
}
__device__ __forceinline__ void xcd_barrier(const XcdBarrier& b) {
    asm volatile("s_waitcnt vmcnt(0)" ::: "memory");
    __syncthreads();
    if (threadIdx.x == 0) {
        unsigned* bar = b.bar; unsigned bx = b.x; asm volatile("" : "+s"(bar), "+s"(bx));
        __builtin_amdgcn_s_waitcnt(0);
        unsigned nloc = b.st[0], nx = b.st[1];
        if (nloc == 0u) { xcd_barrier_complete(bar, bx, nloc, nx); b.st[0] = nloc; b.st[1] = nx; }
        const unsigned old = xb_add(&bar[XB_XSUB(bx)], 1u);
        const unsigned gen = old / nloc;
        if (old + 1u == (gen + 1u) * nloc) {
            __builtin_amdgcn_fence(__ATOMIC_RELEASE, "agent");
            asm volatile("s_waitcnt vmcnt(0)" ::: "memory");
            const unsigned og = xb_add(&bar[XB_TOP], 1u);
            const unsigned tg = og / nx;
            if (og + 1u == (tg + 1u) * nx) xb_add(&bar[XB_TOPGEN], 1u);
            else XB_SPIN(xb_ld(&bar[XB_TOPGEN]) == tg, bar);
            __builtin_amdgcn_fence(__ATOMIC_ACQUIRE, "agent");
            xb_add(&bar[XB_XGEN(bx)], 1u);
            asm volatile("s_waitcnt vmcnt(0)" ::: "memory");
        } else {
            XB_SPIN(xb_ld(&bar[XB_XGEN(bx)]) == gen, bar);
            __builtin_amdgcn_fence(__ATOMIC_ACQUIRE, "agent");
            asm volatile("s_waitcnt vmcnt(0)" ::: "memory");
        }
    }
    __syncthreads();
}


#ifndef DBG_STOP
#define DBG_STOP 0
#endif
constexpr size_t OUTN = (size_t)NB * SEQ * DM;
__device__ __forceinline__ void dbg_dump_f32(float* out, const float* src, size_t n, int gtid, int gn) {
    for (size_t i = gtid; i < OUTN; i += gn) { float s = 0.f; for (size_t k = i; k < n; k += OUTN) s += src[k]; out[i] = s; } }
__device__ __forceinline__ void dbg_dump_bf16(float* out, const bf16_t* src, size_t n, int gtid, int gn) {
    for (size_t i = gtid; i < OUTN; i += gn) { float s = 0.f; for (size_t k = i; k < n; k += OUTN) s += __uint_as_float((unsigned)src[k] << 16); out[i] = s; } }
#define DBG_AT(N, CALL) do { if (p.dbg == (N) && l == 0) { const int gtid = blockIdx.x * 512 + threadIdx.x, gn = gridDim.x * 512; CALL; return; } } while (0)

struct Params { const float* in[25]; float* out; unsigned char* ws; int dbg, pad; };
enum { I_X = 0, I_C, I_CTX, I_CCTX, I_WMOD, I_BMOD, I_NMIX, I_NFFN, I_WIN, I_LQ1, I_LK1, I_LQ2, I_LK2, I_SUBLN, I_QN, I_KN, I_POOLW, I_POOLS, I_GON, I_WOUT, I_WUP, I_CONVW, I_CONVB, I_WDN, I_FN };

constexpr int LDS_BYTES = 147456;

template <int MODE>
__device__ __forceinline__ void transpose_item(const float* W, int K, int N, bf16_t* WT, LAS float* scr, int item, int lane,
                                               const float* subln, const float* pools, const float* gon, float one_m_li) {
    const int nblk = N / 32, kb = item / nblk, nb = item % nblk, k0 = 64 * kb, n0 = 32 * nb;
    float wv[32];
#pragma unroll
    for (int i = 0; i < 32; ++i) { const int kk = 2 * i + (lane >> 5); wv[i] = W[(size_t)(k0 + kk) * N + n0 + (lane & 31)]; }
#pragma unroll
    for (int i = 0; i < 32; ++i) { const int kk = 2 * i + (lane >> 5); float w = wv[i];
        if (MODE == 1) { const int k = k0 + kk; const float s = (k < 768) ? subln[k & 127] * one_m_li : ((k < 1280) ? pools[k - 768] : gon[k - 1280]); w *= s; }
        scr[kk * 33 + (lane & 31)] = w; }
    asm volatile("s_waitcnt lgkmcnt(0)" ::: "memory");
    const int c = lane & 7;
#pragma unroll
    for (int j = 0; j < 4; ++j) { const int n = (lane >> 3) + 8 * j; const LAS float* s = scr + (8 * c) * 33 + n;
        u32x4 o; o.x = cvt_pk_bf16(s[0 * 33], s[1 * 33]); o.y = cvt_pk_bf16(s[2 * 33], s[3 * 33]); o.z = cvt_pk_bf16(s[4 * 33], s[5 * 33]); o.w = cvt_pk_bf16(s[6 * 33], s[7 * 33]);
        int nd = n0 + n; if (MODE == 2) { const int half = n0 >= DFF ? 1 : 0, rem = n0 - half * DFF; nd = (rem >> 7) * 256 + half * 128 + (rem & 127) + n; }
        *(u32x4*)(WT + (size_t)nd * K + k0 + 8 * c) = o; }
    asm volatile("s_waitcnt lgkmcnt(0)" ::: "memory");
}

template <int MODE>
__device__ __forceinline__ void transpose_matrix(const float* W, int K, int N, bf16_t* WT, LAS float* scr, int lane, int worker, int nworkers,
                                                 const float* subln, const float* pools, const float* gon, float one_m_li) {
    const int items = (K / 64) * (N / 32);
    for (int it = worker; it < items; it += nworkers) transpose_item<MODE>(W, K, N, WT, scr, it, lane, subln, pools, gon, one_m_li);
}
#define CONVERT_OUT_UP_DOWN(l_, worker_, nworkers_) do { const int l__ = (l_); const float li__ = l__ == 0 ? 0.2f : 0.35550906759f; LAS float* scr__ = (LAS float*)(L + wave * 8704); \
    transpose_matrix<1>(p.in[I_WOUT] + (size_t)l__ * MIXW * DM, MIXW, DM, (bf16_t*)(ws + WS_WOUT) + (size_t)l__ * DM * MIXW, scr__, lane, (worker_), (nworkers_), p.in[I_SUBLN] + l__ * 128, p.in[I_POOLS] + l__ * 512, p.in[I_GON] + l__ * 768, 1.f - li__); \
    transpose_matrix<2>(p.in[I_WUP] + (size_t)l__ * DM * DFF2, DM, DFF2, (bf16_t*)(ws + WS_WUP) + (size_t)l__ * DFF2 * DM, scr__, lane, (worker_), (nworkers_), nullptr, nullptr, nullptr, 0.f); \
    transpose_matrix<0>(p.in[I_WDN] + (size_t)l__ * DFF * DM, DFF, DM, (bf16_t*)(ws + WS_WDN) + (size_t)l__ * DM * DFF, scr__, lane, (worker_), (nworkers_), nullptr, nullptr, nullptr, 0.f); } while (0)
#define CONVERT_IN(l_, worker_, nworkers_) do { const int l__ = (l_); LAS float* scr__ = (LAS float*)(L + wave * 8704); \
    transpose_matrix<0>(p.in[I_WIN] + (size_t)l__ * DM * INC, DM, INC, (bf16_t*)(ws + WS_WIN) + (size_t)l__ * INC * DM, scr__, lane, (worker_), (nworkers_), nullptr, nullptr, nullptr, 0.f); } while (0)

__device__ __forceinline__ void norm_phase(float* X, bf16_t* H, const float* gain, const float* mod_l, int shift_off, int scale_off, int gw, int NGW, int lane, bool skip_ctx, const float* part, const float* pgate,
                                           const float* xlat  , const float* xctx  ) {
    for (int m = gw; m < MROWS; m += NGW) {
        const int b = m / TOK, t = m - b * TOK; const int r = t < CTX ? 4 : b;
        if (skip_ctx && t < CTX) continue;
        float* xr = X + (size_t)m * DM + lane * 4;
        const float* xs = xr;
        if (t < CTX) { if (xctx) xs = xctx + ((size_t)b * CTX + t) * DM + lane * 4; } else { if (xlat) xs = xlat + ((size_t)b * SEQ + (t - CTX)) * DM + lane * 4; }
        f32x4 v[8]; float ss = 0.f;
#pragma unroll
        for (int j = 0; j < 8; ++j) v[j] = *(const f32x4*)(xs + j * 256);
        if (part != nullptr && t < CTX) {
            const float* pr = part + (size_t)(b * 256 + t) * DM + lane * 4;
#pragma unroll
            for (int j = 0; j < 8; ++j) { f32x4 a = *(const f32x4*)(pr + j * 256);
#pragma unroll
                for (int ks = 1; ks < 8; ++ks) a += *(const f32x4*)(pr + (size_t)ks * 1024 * DM + j * 256);
                v[j] += *(const f32x4*)(pgate + lane * 4 + j * 256) * a; *(f32x4*)(xr + j * 256) = v[j]; }
        }
#pragma unroll
        for (int j = 0; j < 8; ++j) ss += (v[j].x * v[j].x + v[j].y * v[j].y) + (v[j].z * v[j].z + v[j].w * v[j].w);
        const float rstd = 1.0f / sqrtf(wave_sum(ss) * (1.f / DM) + EPS);
        const float* mr = mod_l + (size_t)r * NMOD6 + lane * 4;
        bf16_t* hr = H + (size_t)m * DM + lane * 4;
#pragma unroll
        for (int j = 0; j < 8; ++j) { const f32x4 g = *(const f32x4*)(gain + lane * 4 + j * 256), sc = *(const f32x4*)(mr + scale_off + j * 256), sh = *(const f32x4*)(mr + shift_off + j * 256);
            const f32x4 y = (v[j] * rstd * g) * (1.f + sc) + sh;
            u32x2 w; w.x = cvt_pk_bf16(y.x, y.y); w.y = cvt_pk_bf16(y.z, y.w); *(u32x2*)(hr + j * 256) = w; }
    }
}

#define MOD_GEMV(TASK_FIRST, TASK_END, TASK_STEP) do { \
        LAS float* scv = (LAS float*)(L + 69632);              \
        LAS float* red = (LAS float*)(L + 69632 + 40960);      \
        for (int i = tid; i < 5 * DM; i += 512) { const int r = i >> 11, k = i & 2047; const float v = r < 4 ? p.in[I_C][r * DM + k] : p.in[I_CCTX][k]; scv[i] = silu_f(v); } \
        __syncthreads(); \
        for (int task = (TASK_FIRST); task < (TASK_END); task += (TASK_STEP)) { \
            const int l = task / 96, j0 = (task % 96) * 128; \
            const float* wp = p.in[I_WMOD] + ((size_t)l * DM + wave * 256) * NMOD6 + j0 + lane * 2; \
            f32x2 a0 = {0.f, 0.f}, a1 = a0, a2 = a0, a3 = a0, a4 = a0; \
            _Pragma("unroll 16") \
            for (int k = 0; k < 256; ++k) { const f32x2 w = *(const f32x2*)(wp + (size_t)k * NMOD6); const int kk = wave * 256 + k; \
                a0 += scv[kk] * w; a1 += scv[2048 + kk] * w; a2 += scv[4096 + kk] * w; a3 += scv[6144 + kk] * w; a4 += scv[8192 + kk] * w; } \
            LAS float* rw = red + wave * 640 + lane * 2; \
            rw[0] = a0.x; rw[1] = a0.y; rw[128] = a1.x; rw[129] = a1.y; rw[256] = a2.x; rw[257] = a2.y; rw[384] = a3.x; rw[385] = a3.y; rw[512] = a4.x; rw[513] = a4.y; \
            __syncthreads(); \
            for (int i = tid; i < 640; i += 512) { const int r = i >> 7, jj = i & 127; float s_ = p.in[I_BMOD][l * NMOD6 + j0 + jj]; \
                _Pragma("unroll") for (int q = 0; q < 8; ++q) s_ += red[q * 640 + i]; \
                MOD[((size_t)l * 5 + r) * NMOD6 + j0 + jj] = s_; } \
            __syncthreads(); \
        } } while (0)

__global__ void __launch_bounds__(512, 2) fwd_megakernel(Params p) {
    extern __shared__ __attribute__((aligned(16))) unsigned char lds[];
    cg::grid_group grid = cg::this_grid();
    const int G = gridDim.x, NGW = G * 8;
#define FRESH_IDS() int tid = threadIdx.x; asm volatile("" : "+v"(tid)); const int lane = tid & 63, wave = __builtin_amdgcn_readfirstlane(tid >> 6); int bid = blockIdx.x; asm volatile("" : "+s"(bid)); const int gw = bid * 8 + wave; (void)lane; (void)gw;
    unsigned char* ws = p.ws;
    float* MOD = (float*)(ws + WS_MOD);
    float* X = (float*)(ws + WS_X);
    bf16_t* H = (bf16_t*)(ws + WS_H);
    bf16_t* ACT = (bf16_t*)(ws + WS_ACT);
    bf16_t* U = (bf16_t*)(ws + WS_U);
    bf16_t* PROJ = (bf16_t*)(ws + WS_PROJ);
    float* AO = (float*)(ws + WS_AO);
    bf16_t* MRG = (bf16_t*)(ws + WS_MRG);
    float* PART = (float*)(ws + WS_PART);
    bf16_t* EDGE = (bf16_t*)(ws + WS_U + 190 * MiB);
    LAS unsigned char* L = (LAS unsigned char*)lds;
    volatile LAS unsigned* MISC = (volatile LAS unsigned*)(L + LDS_BYTES - 64);
    if (threadIdx.x < 16) MISC[threadIdx.x] = 0u;
    __syncthreads();
    if (blockIdx.x == 0 && threadIdx.x < 64) { unsigned* bw = (unsigned*)(ws + WS_CTL);
        for (int i = threadIdx.x; i < XCD_BAR_WORDS; i += 64) __hip_atomic_store(bw + i, 0u, __ATOMIC_RELAXED, __HIP_MEMORY_SCOPE_AGENT);
        asm volatile("s_waitcnt vmcnt(0)" ::: "memory"); }
    __syncthreads();
    grid.sync();
    XcdBarrier xbar = xcd_barrier_post((unsigned*)(ws + WS_CTL), MISC);
#define GRID_SYNC() xcd_barrier(xbar)

    {
        FRESH_IDS();
        if (G == 256) MOD_GEMV(bid, 96, G); else MOD_GEMV(bid, 192, G);
        {
            const bool defer = (G == 256);
            CONVERT_IN(0, gw, NGW);
            { LAS float* scr = (LAS float*)(L + wave * 8704);
              for (int it = gw; it < 64; it += NGW) { const int l2 = it >> 5, r = it & 31, g = r >> 3;
                  transpose_item<0>(p.in[I_POOLW] + ((size_t)l2 * 4 + g) * 16384, 128, 128, (bf16_t*)(ws + WS_WPOOL) + ((size_t)l2 * 4 + g) * 16384, scr, r & 7, lane, nullptr, nullptr, nullptr, 0.f); } }
            if (!defer) { CONVERT_IN(1, gw, NGW); CONVERT_OUT_UP_DOWN(0, gw, NGW); CONVERT_OUT_UP_DOWN(1, gw, NGW); }
        }
    }
    GRID_SYNC();

    for (int l = 0; l < 2; ++l) {
        const bool last = (l == 1);
        const float lambda_init = l == 0 ? 0.2f : 0.35550906759f;
        const float* mod_l = MOD + (size_t)l * 5 * NMOD6;
        { FRESH_IDS(); norm_phase(X, H, p.in[I_NMIX] + l * DM, mod_l, 0, DM, gw, NGW, lane, false, (l == 1 && G == 256) ? PART : nullptr, MOD + 4 * NMOD6 + 5 * DM, l == 0 ? p.in[I_X] : nullptr, l == 0 ? p.in[I_CTX] : nullptr); }
        GRID_SYNC();
        { FRESH_IDS(); pg8::Gemm g{H, (const bf16_t*)(ws + WS_WIN) + (size_t)l * INC * DM, MROWS, INC, DM}; pg8::StaticOrder S; S.init(MROWS / 256, INC / 256, G, bid, 0, DM / 64);
          pg8::EpiBf16 E{PROJ, INC}; pg8::gemm_phase<pg8::EpiBf16, pg8::StaticOrder, true, true>(L, g, S, E, tid);
          if (l == 0 && G == 256 && bid >= 64) { __syncthreads(); CONVERT_OUT_UP_DOWN(0, (bid - 64) * 8 + wave, 192 * 8); } }
        GRID_SYNC();
        {
            FRESH_IDS();
            const float* qn = p.in[I_QN] + l * 128; const float* kn = p.in[I_KN] + l * 128;
            for (int m = gw; m < MROWS; m += NGW) {
                const int b = m / TOK, t = m - b * TOK; const bool lat = t >= CTX; const int s = t - CTX; const float prow = (float)(s >> 6), pcol = (float)(s & 63);
                bf16_t* pr = PROJ + (size_t)m * INC;
                if (lat) {
                    for (int pc = lane; pc < 96; pc += 64) { const int blk = pc >> 1, c = pc & 1; bf16_t* a = pr + blk * 32 + c * 8;
                        const float pos = (blk & 1) ? pcol : prow;
                        u32x4 va = *(const u32x4*)a, vb = *(const u32x4*)(a + 16); u32x4 oa, ob;
#pragma unroll
                        for (int e2 = 0; e2 < 4; ++e2) { float y1[2], y2[2];
#pragma unroll
                            for (int h = 0; h < 2; ++h) { const int i = c * 8 + e2 * 2 + h; const float x1 = h ? bfhi(va[e2]) : bflo(va[e2]), x2 = h ? bfhi(vb[e2]) : bflo(vb[e2]);
                                const float fr_ = __builtin_amdgcn_exp2f(-(float)i * (13.287712379549449f / 16.f)) * 0.15915494309189535f; float rev = pos * fr_; rev -= floorf(rev);
                                const float sn = __builtin_amdgcn_sinf(rev), cs = __builtin_amdgcn_cosf(rev);
                                y1[h] = x1 * cs - x2 * sn; y2[h] = x2 * cs + x1 * sn; }
                            oa[e2] = cvt_pk_bf16(y1[0], y1[1]); ob[e2] = cvt_pk_bf16(y2[0], y2[1]); }
                        *(u32x4*)a = oa; *(u32x4*)(a + 16) = ob; }
                }
                { const int head = lane >> 3, sub = lane & 7, blk64 = sub >> 2, c = sub & 3; bf16_t* a = pr + C_GQ + head * 128 + blk64 * 64 + c * 8;
                  const float* gp = (head < 6 ? qn : kn) + blk64 * 64 + c * 8; const float pos = blk64 ? pcol : prow;
                  u32x4 va = *(const u32x4*)a, vb = *(const u32x4*)(a + 32); float x1[8], x2[8]; float ss = 0.f;
#pragma unroll
                  for (int e2 = 0; e2 < 4; ++e2) { x1[2 * e2] = bflo(va[e2]); x1[2 * e2 + 1] = bfhi(va[e2]); x2[2 * e2] = bflo(vb[e2]); x2[2 * e2 + 1] = bfhi(vb[e2]); }
#pragma unroll
                  for (int e = 0; e < 8; ++e) ss += x1[e] * x1[e] + x2[e] * x2[e];
                  ss += __shfl_xor(ss, 1); ss += __shfl_xor(ss, 2); ss += __shfl_xor(ss, 4);
                  const float rstd = 1.0f / sqrtf(ss * (1.f / 128.f) + EPS);
                  u32x4 oa, ob;
#pragma unroll
                  for (int e2 = 0; e2 < 4; ++e2) { float y1[2], y2[2];
#pragma unroll
                      for (int h = 0; h < 2; ++h) { const int e = e2 * 2 + h, i = c * 8 + e; const float a1 = x1[e] * rstd * gp[e], a2 = x2[e] * rstd * gp[32 + e];
                          float sn = 0.f, cs = 1.f;
                          if (lat) { const float fr_ = __builtin_amdgcn_exp2f(-(float)i * (13.287712379549449f / 32.f)) * 0.15915494309189535f; float rev = pos * fr_; rev -= floorf(rev);
                              sn = __builtin_amdgcn_sinf(rev); cs = __builtin_amdgcn_cosf(rev); }
                          y1[h] = a1 * cs - a2 * sn; y2[h] = a2 * cs + a1 * sn; }
                      oa[e2] = cvt_pk_bf16(y1[0], y1[1]); ob[e2] = cvt_pk_bf16(y2[0], y2[1]); }
                  *(u32x4*)a = oa; *(u32x4*)(a + 32) = ob; }
            }
        }
        GRID_SYNC();
        {
            FRESH_IDS();
            float* AO1 = AO; float* AO2 = AO + (size_t)MROWS * 768; float* AOG = AO + (size_t)2 * MROWS * 768;
            for (int step = 0; step < 8; ++step) {
                int u = -1;
                if (G == 256) {
                    if (bid < 192) { if (step == 0) u = bid; else if (step == 1) u = 192 + bid; else if (step == 2 && !last && bid < 72) u = 576 + bid; }
                    else { if (step < 3) u = 192 + 192 + (bid - 192) * 3 + step; }
                } else { const int nu = last ? 576 : 648; const int uu = bid + step * G; if (uu < nu) u = uu; }
                if (u < 0) continue;
                int tid2 = tid; asm volatile("" : "+v"(tid2));
                int b, h, half = 0, qb = 0; const bool isctx = u >= 576; bool gqa;
                if (u < 192) { b = u / 48; const int rem = u % 48; h = rem >> 3; qb = rem & 7; gqa = true; }
                else if (u < 576) { const int v = u - 192; b = v / 96; const int rem = v % 96; h = rem >> 4; half = (rem >> 3) & 1; qb = rem & 7; gqa = false; }
                else if (u < 600) { const int v = u - 576; b = v / 6; h = v % 6; gqa = true; }
                else { const int v = u - 600; b = v / 12; const int rem = v % 12; h = rem >> 1; half = rem & 1; gqa = false; }
                const size_t r0 = (size_t)b * TOK, rq = isctx ? r0 : r0 + CTX + qb * 256; const int seq = isctx ? CTX : TOK;
                if (gqa) { const int kvh = h / 3;
                    att::attn_unit<128>(PROJ + rq * INC + C_GQ + h * 128, PROJ + r0 * INC + C_GK + kvh * 128, PROJ + r0 * INC + C_GV + kvh * 128, AOG + rq * 768 + h * 128, seq, (char*)lds, tid2);
                } else {
                    att::attn_unit<64>(PROJ + rq * INC + C_DAQ + h * 128 + half * 64, PROJ + r0 * INC + C_DAK + h * 128 + half * 64, PROJ + r0 * INC + C_DAV + h * 128, (half ? AO2 : AO1) + rq * 768 + h * 128, seq, (char*)lds, tid2);
                }
            }
        }
        {
            FRESH_IDS();
            const bool fill = (G != 256) || (bid < 192);
            const int pool_first = (G == 256) ? bid : bid, pool_stride = (G == 256) ? 192 : G;
            if (fill) {
                __syncthreads();
                const bf16_t* WP = (const bf16_t*)(ws + WS_WPOOL) + (size_t)l * 4 * 16384;
                LAS unsigned* tin = (LAS unsigned*)L;
                LAS unsigned char* tout = L + 20480;
                for (int it = pool_first; it < 576; it += pool_stride) {
                    const int tile = it >> 2, g = it & 3, m0 = tile * 64, b = m0 / TOK, t0 = m0 - b * TOK; const bool isctx = t0 < CTX;
                    if (last && isctx) continue;
                    const int slo = isctx ? 0 : CTX, shi = isctx ? CTX : TOK;
                    for (int idx = tid; idx < 1280; idx += 512) { const int row = idx >> 4, ch = idx & 15, t = t0 - 8 + row;
                        u32x4 v = {0u, 0u, 0u, 0u};
                        if (t >= slo && t < shi) v = *(const u32x4*)(PROJ + (size_t)(b * TOK + t) * INC + C_POOL + g * 128 + ch * 8);
                        *(LAS u32x4*)(tin + row * 64 + ch * 4) = v; }
                    bf16x8 wfr[4][4];
#pragma unroll
                    for (int q = 0; q < 4; ++q)
#pragma unroll
                        for (int ks = 0; ks < 4; ++ks) wfr[q][ks] = *(const bf16x8*)(WP + (size_t)g * 16384 + (size_t)(((wave & 1) * 4 + q) * 16 + (lane & 15)) * 128 + ks * 32 + (lane >> 4) * 8);
                    __syncthreads();
                    { const int w = 2 << g, hw = w >> 1, Tn = shi - slo, p0 = t0 - slo;
    #pragma unroll 1
                      for (int rr = 0; rr < 8; ++rr) { const int r = wave * 8 + rr, pp = p0 + r;
                          int lo = pp - hw; lo = lo < 0 ? 0 : lo; int hi2 = pp - hw + w; hi2 = hi2 > Tn ? Tn : hi2;
                          float s0 = 0.f, s1 = 0.f;
                          for (int j = lo; j < hi2; ++j) { const unsigned u = tin[(j - p0 + 8) * 64 + lane]; s0 += bflo(u); s1 += bfhi(u); }
                          const unsigned uc = tin[(r + 8) * 64 + lane]; const float inv = 1.0f / (float)(hi2 - lo);
                          *(LAS unsigned*)(tout + r * 272 + lane * 4) = cvt_pk_bf16(s0 * inv - bflo(uc), s1 * inv - bfhi(uc)); } }
                    __syncthreads();
                    { const int rb = wave >> 1, fr = lane & 15, fq = lane >> 4;
    #pragma unroll
                      for (int q = 0; q < 4; ++q) { const int nb = (wave & 1) * 4 + q; f32x4 acc = {0.f, 0.f, 0.f, 0.f};
    #pragma unroll
                          for (int ks = 0; ks < 4; ++ks) { const bf16x8 af = *(const LAS bf16x8*)(tout + (rb * 16 + fr) * 272 + (ks * 32 + fq * 8) * 2);
                              acc = __builtin_amdgcn_mfma_f32_16x16x32_bf16(wfr[q][ks], af, acc, 0, 0, 0); }
                          u32x2 o; o.x = cvt_pk_bf16(acc[0], acc[1]); o.y = cvt_pk_bf16(acc[2], acc[3]);
                          *(u32x2*)(MRG + (size_t)(m0 + rb * 16 + fr) * MIXW + 768 + g * 128 + nb * 16 + 4 * fq) = o; } }
                    __syncthreads();
                }

                if (l == 0 && G == 256) CONVERT_IN(1, bid * 8 + wave, 192 * 8);
                if (l == 0 && G == 256 && bid >= 96) { __syncthreads(); MOD_GEMV(bid, 192, 256); }
            }
        }
        GRID_SYNC();
        {
            FRESH_IDS();
            const float* AO1 = AO; const float* AO2 = AO + (size_t)MROWS * 768; const float* AOG = AO + (size_t)2 * MROWS * 768;
            const float s1 = wave_sum(p.in[I_LQ1][l * 64 + lane] * p.in[I_LK1][l * 64 + lane]), s2 = wave_sum(p.in[I_LQ2][l * 64 + lane] * p.in[I_LK2][l * 64 + lane]);
            const float lam = expf(s1) - expf(s2) + lambda_init;
            for (int m = gw; m < MROWS; m += NGW) {
                const int b = m / TOK, t = m - b * TOK; if (last && t < CTX) continue;
                bf16_t* mr = MRG + (size_t)m * MIXW + lane * 2;
                f32x2 da[6], db[6], v[6];
#pragma unroll
                for (int h = 0; h < 6; ++h) { da[h] = *(const f32x2*)(AO1 + (size_t)m * 768 + h * 128 + lane * 2); db[h] = *(const f32x2*)(AO2 + (size_t)m * 768 + h * 128 + lane * 2); v[h] = *(const f32x2*)(AOG + (size_t)m * 768 + h * 128 + lane * 2); }
                float ssd[6], ss = 0.f;
#pragma unroll
                for (int h = 0; h < 6; ++h) { da[h] = da[h] - lam * db[h]; ssd[h] = da[h].x * da[h].x + da[h].y * da[h].y; ss += v[h].x * v[h].x + v[h].y * v[h].y; }
#pragma unroll
                for (int o = 1; o < 64; o <<= 1) {
#pragma unroll
                    for (int h = 0; h < 6; ++h) ssd[h] += __shfl_xor(ssd[h], o);
                    ss += __shfl_xor(ss, o); }
#pragma unroll
                for (int h = 0; h < 6; ++h) { const float rs = 1.0f / sqrtf(ssd[h] * (1.f / 128.f) + EPS); *(unsigned*)(mr + h * 128) = cvt_pk_bf16(da[h].x * rs, da[h].y * rs); }
                const float rstd = 1.0f / sqrtf(ss * (1.f / 768.f) + EPS);
#pragma unroll
                for (int j = 0; j < 6; ++j) *(unsigned*)(mr + 1280 + j * 128) = cvt_pk_bf16(v[j].x * rstd, v[j].y * rstd);
            }
        }
        GRID_SYNC();
        { FRESH_IDS(); pg8::Gemm g{MRG, (const bf16_t*)(ws + WS_WOUT) + (size_t)l * DM * MIXW, MROWS, DM, MIXW}; pg8::StaticOrder S; S.init(last ? 32 : 36, DM / 256, G, bid, last ? 1 : 0, MIXW / 64, (!last && G == 256) ? 1 : 0);
          pg8::EpiResid E{X, mod_l + 2 * DM, PART, l == 0 ? p.in[I_X] : nullptr, l == 0 ? p.in[I_CTX] : nullptr}; pg8::gemm_phase<pg8::EpiResid, pg8::StaticOrder, true, true>(L, g, S, E, tid); }
        GRID_SYNC();
        { FRESH_IDS(); norm_phase(X, H, p.in[I_NFFN] + l * DM, mod_l, 3 * DM, 4 * DM, gw, NGW, lane, last, (l == 0 && G == 256) ? PART : nullptr, mod_l + 4 * NMOD6 + 2 * DM, nullptr, (l == 0 && G == 256) ? p.in[I_CTX] : nullptr); }
        GRID_SYNC();
        { FRESH_IDS(); pg8::Gemm g{H, (const bf16_t*)(ws + WS_WUP) + (size_t)l * DFF2 * DM, MROWS, DFF2, DM}; pg8::StaticOrder S; S.init(last ? 32 : 36, DFF2 / 256, G, bid, last ? 1 : 0, DM / 64);
          pg8::EpiConvAct E{ACT, EDGE, p.in[I_CONVW] + (size_t)l * 3 * DFF2, p.in[I_CONVB] + (size_t)l * DFF2, (LAS float*)(L + 131072)}; pg8::gemm_phase<pg8::EpiConvAct, pg8::StaticOrder, true, true>(L, g, S, E, tid);
          if (l == 0 && G == 256 && bid >= 48) { __syncthreads(); CONVERT_OUT_UP_DOWN(1, (bid - 48) * 8 + wave, 208 * 8); } }
        GRID_SYNC();
        {
            FRESH_IDS();
            pg8::StaticOrder S; S.init(last ? 32 : 36, DM / 256, G, bid, last ? 1 : 0, DFF / 64, (!last && G == 256) ? 1 : 0);
            const float* cw = p.in[I_CONVW] + (size_t)l * 3 * DFF2; const float* cb = p.in[I_CONVB] + (size_t)l * DFF2;
            pg8::Unit uu;
            for (int i = 0; S.next(i, uu); ++i) { const int pm = uu.pm, j = pm % 9 - 1; if (j < 0) continue;
                for (int idx = tid; idx < 2 * 704; idx += 512) { const int which = idx >= 704 ? 1 : 0, col = (idx - which * 704) * 8;
                    if (which == 0 ? (j == 0) : (j == 7)) continue;
                    const bf16_t* ru = which == 0 ? EDGE + (size_t)((pm - 1) * 4 + 3) * DFF2 : EDGE + (size_t)(pm * 4 + 2) * DFF2;
                    const bf16_t* rm = which == 0 ? EDGE + (size_t)(pm * 4 + 0) * DFF2 : EDGE + (size_t)(pm * 4 + 3) * DFF2;
                    const bf16_t* rd = which == 0 ? EDGE + (size_t)(pm * 4 + 1) * DFF2 : EDGE + (size_t)((pm + 1) * 4 + 0) * DFF2;
                    const u32x4 gu = *(const u32x4*)(ru + col), gm = *(const u32x4*)(rm + col), gd = *(const u32x4*)(rd + col);
                    const u32x4 vu = *(const u32x4*)(ru + DFF + col), vm = *(const u32x4*)(rm + DFF + col), vd = *(const u32x4*)(rd + DFF + col);
                    u32x4 o;
#pragma unroll
                    for (int e2 = 0; e2 < 4; ++e2) { float res[2];
                        const f32x2 wg0 = *(const f32x2*)(cw + col + e2 * 2), wg1 = *(const f32x2*)(cw + DFF2 + col + e2 * 2), wg2 = *(const f32x2*)(cw + 2 * DFF2 + col + e2 * 2), bg = *(const f32x2*)(cb + col + e2 * 2);
                        const f32x2 wv0 = *(const f32x2*)(cw + DFF + col + e2 * 2), wv1 = *(const f32x2*)(cw + DFF2 + DFF + col + e2 * 2), wv2 = *(const f32x2*)(cw + 2 * DFF2 + DFF + col + e2 * 2), bv = *(const f32x2*)(cb + DFF + col + e2 * 2);
#pragma unroll
                        for (int h = 0; h < 2; ++h) {
                            const float g0 = h ? bfhi(gu[e2]) : bflo(gu[e2]), g1 = h ? bfhi(gm[e2]) : bflo(gm[e2]), g2 = h ? bfhi(gd[e2]) : bflo(gd[e2]);
                            const float v0 = h ? bfhi(vu[e2]) : bflo(vu[e2]), v1 = h ? bfhi(vm[e2]) : bflo(vm[e2]), v2 = h ? bfhi(vd[e2]) : bflo(vd[e2]);
                            const float gg = wg0[h] * g0 + wg1[h] * g1 + wg2[h] * g2 + bg[h];
                            const float vv = wv0[h] * v0 + wv1[h] * v1 + wv2[h] * v2 + bv[h];
                            res[h] = silu_f(gg) * vv; }
                        o[e2] = cvt_pk_bf16(res[0], res[1]); }
                    *(u32x4*)(ACT + (size_t)(pm * 256 + (which ? 255 : 0)) * DFF + col) = o; } }
            asm volatile("s_waitcnt vmcnt(0)" ::: "memory"); __syncthreads();
        }
        { FRESH_IDS(); pg8::Gemm g{ACT, (const bf16_t*)(ws + WS_WDN) + (size_t)l * DM * DFF, MROWS, DM, DFF}; pg8::StaticOrder S; S.init(last ? 32 : 36, DM / 256, G, bid, last ? 1 : 0, DFF / 64, (!last && G == 256) ? 1 : 0);
          pg8::EpiResid E{X, mod_l + 5 * DM, PART, nullptr, nullptr}; pg8::gemm_phase<pg8::EpiResid, pg8::StaticOrder, true, true>(L, g, S, E, tid); }
        GRID_SYNC();
    }
    { FRESH_IDS();
    for (int i = gw; i < NB * SEQ; i += NGW) { const int b = i / SEQ, s = i - b * SEQ; const float* xr = X + ((size_t)b * TOK + CTX + s) * DM + lane * 4;
        f32x4 v[8]; float ss = 0.f;
#pragma unroll
        for (int j = 0; j < 8; ++j) { v[j] = *(const f32x4*)(xr + j * 256); ss += (v[j].x * v[j].x + v[j].y * v[j].y) + (v[j].z * v[j].z + v[j].w * v[j].w); }
        const float rstd = 1.0f / sqrtf(wave_sum(ss) * (1.f / DM) + EPS);
        float* orow = p.out + (size_t)i * DM + lane * 4;
#pragma unroll
        for (int j = 0; j < 8; ++j) { const f32x4 g = *(const f32x4*)(p.in[I_FN] + lane * 4 + j * 256); *(f32x4*)(orow + j * 256) = v[j] * rstd * g; } } }
}

extern "C" void kernel_launch(void* const* d_in, const int* in_sizes, int n_in, void* d_out, int out_size, void* d_ws, size_t ws_size, hipStream_t stream) {
    static int grid_blocks = 0;
    if (grid_blocks == 0) {
        if (n_in != 25 || ws_size < WS_END) { fprintf(stderr, "kernel_launch: n_in %d ws %zu (need %zu)\n", n_in, ws_size, (size_t)WS_END); grid_blocks = -1; return; }
        int dev = 0, cus = 0, per_cu = 0;
        hipGetDevice(&dev); hipDeviceGetAttribute(&cus, hipDeviceAttributeMultiprocessorCount, dev);
        if (hipFuncSetAttribute((const void*)fwd_megakernel, hipFuncAttributeMaxDynamicSharedMemorySize, LDS_BYTES) != hipSuccess) { fprintf(stderr, "kernel_launch: hipFuncSetAttribute failed\n"); grid_blocks = -1; return; }
        if (hipOccupancyMaxActiveBlocksPerMultiprocessor(&per_cu, (const void*)fwd_megakernel, 512, LDS_BYTES) != hipSuccess || per_cu < 1) { fprintf(stderr, "kernel_launch: occupancy query says %d\n", per_cu); per_cu = 1; }
        (void)hipGetLastError();
        grid_blocks = cus * 1;
        fprintf(stderr, "kernel_launch: cus %d per_cu %d grid %d\n", cus, per_cu, grid_blocks);
    }
    if (grid_blocks < 0) return;
    Params p{};
    for (int i = 0; i < 25; ++i) p.in[i] = (const float*)d_in[i];
    p.out = (float*)d_out; p.ws = (unsigned char*)d_ws; p.dbg = DBG_STOP;
    void* args[] = {&p};
    hipError_t e = hipLaunchCooperativeKernel((const void*)fwd_megakernel, dim3(grid_blocks), dim3(512), args, LDS_BYTES, stream);
    if (e != hipSuccess) fprintf(stderr, "cooperative launch failed: %s (grid %d)\n", hipGetErrorString(e), grid_blocks);
}
```

```cpp
#include <hip/hip_runtime.h>
#include <hip/hip_cooperative_groups.h>
#include <cstdio>
#include <cstdint>
namespace cg = cooperative_groups;

#define LAS __attribute__((address_space(3)))
typedef unsigned short bf16_t;
typedef short bf16x8 __attribute__((ext_vector_type(8)));
typedef short s16x4 __attribute__((ext_vector_type(4)));
typedef float f32x2 __attribute__((ext_vector_type(2)));
typedef float f32x4 __attribute__((ext_vector_type(4)));
typedef float f32x16 __attribute__((ext_vector_type(16)));
typedef unsigned u32x2 __attribute__((ext_vector_type(2)));
typedef unsigned u32x4 __attribute__((ext_vector_type(4)));

constexpr int NB = 4, SEQ = 2048, CTX = 256, TOK = SEQ + CTX  , MROWS = NB * TOK  ;
constexpr int DM = 2048, INC = 4096, MIXW = 2048, DFF = 5632, DFF2 = 11264, NMOD6 = 6 * DM  ;
constexpr int C_DAQ = 0, C_DAK = 768, C_DAV = 1536, C_POOL = 2304, C_GQ = 2816, C_GK = 3584, C_GV = 3840;
constexpr float EPS = 1e-6f;

constexpr size_t MiB = 1u << 20;
constexpr size_t WS_MOD = 0;
constexpr size_t WS_CTL = 512 * 1024, CTL_BYTES = 16384;
constexpr size_t WS_WPOOL = 1 * MiB;
constexpr size_t WS_WIN = 2 * MiB;
constexpr size_t WS_WOUT = WS_WIN + 32 * MiB;
constexpr size_t WS_WUP = WS_WOUT + 16 * MiB;
constexpr size_t WS_WDN = WS_WUP + 88 * MiB;
constexpr size_t WS_X = WS_WDN + 44 * MiB;
constexpr size_t WS_H = WS_X + 72 * MiB;
constexpr size_t WS_ACT = WS_H + 36 * MiB;
constexpr size_t WS_U = WS_ACT + 99 * MiB;
constexpr size_t WS_PROJ = WS_U;
constexpr size_t WS_AO = WS_PROJ + 72 * MiB;
constexpr size_t WS_MRG = WS_AO + 81 * MiB;
constexpr size_t WS_PART = WS_U + 198 * MiB;
constexpr size_t WS_END = WS_PART + 64 * MiB;
static_assert(WS_MRG + 36 * MiB <= WS_PART, "overlay");

typedef __bf16 bf16x2_t __attribute__((ext_vector_type(2)));
__device__ __forceinline__ unsigned cvt_pk_bf16(float lo, float hi) { f32x2 v = {lo, hi}; bf16x2_t b = __builtin_convertvector(v, bf16x2_t); return __builtin_bit_cast(unsigned, b); }
__device__ __forceinline__ float bflo(unsigned w) { return __uint_as_float(w << 16); }
__device__ __forceinline__ float bfhi(unsigned w) { return __uint_as_float(w & 0xffff0000u); }
__device__ __forceinline__ float wave_sum(float v) {
#pragma unroll
    for (int o = 1; o < 64; o <<= 1) v += __shfl_xor(v, o);
    return v;
}
__device__ __forceinline__ float silu_f(float v) { return v * __builtin_amdgcn_rcpf(1.f + __expf(-v)); }

namespace pg8 {
constexpr int BM = 256, BK = 64, HALF = 128, HTB = HALF * BK * 2, STAGE_BYTES = 8 * HTB, NXCD = 8, WGM = 8;
__host__ __device__ __forceinline__ int lds_byte(int r, int c) { const int st = (r >> 4) * 2 + (c >> 5), rr = r & 15, cc = c & 31, ob = rr * 64 + cc * 2; return st * 1024 + (ob ^ (((ob >> 9) & 1) << 5)); }
__host__ __device__ __forceinline__ void stage_rc(int b, int& R, int& C) { const int st = b / 1024, sb = b % 1024, swz = sb ^ (((sb >> 9) & 1) << 5); R = (st >> 1) * 16 + swz / 64; C = (st & 1) * 32 + (swz % 64) / 2; }
__host__ __device__ __forceinline__ int perm32(int rho) { const int n = rho >> 4, i = rho & 15; return 8 * (i >> 2) + 4 * n + (i & 3); }

struct Unit { int pm, pn, kt0, ktn, atomic, ks; };
struct Gemm { const bf16_t* A; const bf16_t* Bt; int M, N, K; };

struct StaticOrder {
    int nM, nN, nwg, G, c, skip;
    int nt, splitctx;
    __device__ __forceinline__ void init(int nM_, int nN_, int G_, int c_, int skip_, int nt_, int splitctx_ = 0) { nM = nM_; nN = nN_; nwg = nM * nN; G = G_; c = c_; skip = skip_; nt = nt_; splitctx = splitctx_; }
    __device__ __forceinline__ bool next(int i, Unit& u) const {
        u.kt0 = 0; u.ktn = nt; u.atomic = 0; u.ks = 0;
        if (splitctx) {
            if (i == 0) { const int rt = (c & 7) * 4 + (c >> 6); u.pm = (rt >> 3) * 9 + 1 + (rt & 7); u.pn = (c >> 3) & 7; return true; }
            if (i == 1) { const int cu = c >> 3, ks = c & 7; u.pm = (cu >> 3) * 9; u.pn = cu & 7; u.atomic = 1; u.ks = ks;
                if (nt == 32) { u.kt0 = 4 * ks; u.ktn = 4; } else { u.kt0 = 11 * ks + (ks & 1); u.ktn = (ks & 1) ? 10 : 12; }
                return true; }
            return false;
        }
        const long L = (long)i * G + c; if (L >= nwg) return false;
        int wgid = (int)L; { const int q = nwg / NXCD, r = nwg % NXCD, xcd = wgid % NXCD, off = wgid / NXCD; wgid = (xcd < r ? xcd * (q + 1) : r * (q + 1) + (xcd - r) * q) + off; }
        const int nig = WGM * nN, gid = wgid / nig, fm = gid * WGM, gsz = (nM - fm) < WGM ? (nM - fm) : WGM;
        int pm = fm + ((wgid % nig) % gsz); u.pn = (wgid % nig) / gsz;
        if (skip) pm = (pm >> 3) * 9 + 1 + (pm & 7);
        u.pm = pm; return true;
    }
    __device__ __forceinline__ void a_ready(const Unit&) const {}
    __device__ __forceinline__ void done(const Unit&) const {}
};

struct EpiBf16 {
    static constexpr bool PERM = true, AFTER_DRAIN = false;
    bf16_t* O; int ldc;
    __device__ __forceinline__ void operator()(const f32x4 (&acc)[2][2][4][2], const Unit& u, int wr, int wc, int fr, int fq) const {
        const int row0 = u.pm * BM + wr * 64 + fr; const int col0 = u.pn * BM + wc * 32 + 8 * fq;
#pragma unroll
        for (int ai = 0; ai < 2; ++ai)
#pragma unroll
            for (int m = 0; m < 4; ++m) { bf16_t* rowp = O + (size_t)(row0 + ai * HALF + m * 16) * ldc + col0;
#pragma unroll
                for (int bj = 0; bj < 2; ++bj) { const f32x4 v0 = acc[ai][bj][m][0], v1 = acc[ai][bj][m][1];
                    u32x4 w; w.x = cvt_pk_bf16(v0[0], v0[1]); w.y = cvt_pk_bf16(v0[2], v0[3]); w.z = cvt_pk_bf16(v1[0], v1[1]); w.w = cvt_pk_bf16(v1[2], v1[3]);
                    *(u32x4*)(rowp + bj * HALF) = w; } }
    }
};
struct EpiConvAct {
    static constexpr bool PERM = true, AFTER_DRAIN = false;
    bf16_t* ACT; bf16_t* EDGE; const float* cw; const float* cb; LAS float* xch;
    __device__ __forceinline__ void operator()(f32x4 (&acc)[2][2][4][2], const Unit& u, int wr, int wc, int fr_, int fq_) const {
        int fr = fr_, fq = fq_; asm volatile("" : "+v"(fr), "+v"(fq));
        const int jc = 32 * wc + 8 * fq, gcol = u.pn * 128 + jc;
        f32x4 Wc[2][4];
#define EPI_LOADW(buf, g) do { const int col_ = ((g) >> 1) * DFF + gcol + 4 * ((g) & 1); Wc[buf][0] = *(const f32x4*)(cw + col_); Wc[buf][1] = *(const f32x4*)(cw + DFF2 + col_); \
            Wc[buf][2] = *(const f32x4*)(cw + 2 * DFF2 + col_); Wc[buf][3] = *(const f32x4*)(cb + col_); } while (0)
        EPI_LOADW(0, 0);
        if (wr == 0 && fr < 2) { bf16_t* e = EDGE + (size_t)(u.pm * 4 + fr) * DFF2 + gcol;
#pragma unroll
            for (int bj = 0; bj < 2; ++bj) { const f32x4 a = acc[0][bj][0][0], b = acc[0][bj][0][1]; u32x4 w; w.x = cvt_pk_bf16(a[0], a[1]); w.y = cvt_pk_bf16(a[2], a[3]); w.z = cvt_pk_bf16(b[0], b[1]); w.w = cvt_pk_bf16(b[2], b[3]); *(u32x4*)(e + bj * DFF) = w; } }
        if (wr == 1 && fr >= 14) { bf16_t* e = EDGE + (size_t)(u.pm * 4 + 2 + (fr - 14)) * DFF2 + gcol;
#pragma unroll
            for (int bj = 0; bj < 2; ++bj) { const f32x4 a = acc[1][bj][3][0], b = acc[1][bj][3][1]; u32x4 w; w.x = cvt_pk_bf16(a[0], a[1]); w.y = cvt_pk_bf16(a[2], a[3]); w.z = cvt_pk_bf16(b[0], b[1]); w.w = cvt_pk_bf16(b[2], b[3]); *(u32x4*)(e + bj * DFF) = w; } }
#pragma unroll
        for (int ai = 0; ai < 2; ++ai) { const int q = ai * 2 + wr;
#pragma unroll
            for (int bj = 0; bj < 2; ++bj)
#pragma unroll
                for (int n = 0; n < 2; ++n) {
                    if (fr == 0)  *(LAS f32x4*)(xch + ((q * 2 + 0) * 2 + bj) * 128 + jc + 4 * n) = acc[ai][bj][0][n];
                    if (fr == 15) *(LAS f32x4*)(xch + ((q * 2 + 1) * 2 + bj) * 128 + jc + 4 * n) = acc[ai][bj][3][n]; } }
        asm volatile("s_waitcnt lgkmcnt(0)" ::: "memory"); __builtin_amdgcn_s_barrier(); asm volatile("" ::: "memory");
#pragma unroll
        for (int g = 0; g < 4; ++g) { const int bj = g >> 1, n = g & 1;
            if (g == 0) EPI_LOADW(1, 1); else if (g == 1) EPI_LOADW(0, 2); else if (g == 2) EPI_LOADW(1, 3);
            const f32x4 w0 = Wc[g & 1][0], w1 = Wc[g & 1][1], w2 = Wc[g & 1][2], bb = Wc[g & 1][3];
#pragma unroll
            for (int ai = 0; ai < 2; ++ai) { const int q = ai * 2 + wr;
                    const int qu = q > 0 ? q - 1 : 0, qd = q < 3 ? q + 1 : 3;
                    f32x4 bup = *(const LAS f32x4*)(xch + ((qu * 2 + 1) * 2 + bj) * 128 + jc + 4 * n), bdn = *(const LAS f32x4*)(xch + ((qd * 2 + 0) * 2 + bj) * 128 + jc + 4 * n);
                    const float mu = q > 0 ? 1.f : 0.f, md = q < 3 ? 1.f : 0.f; bup = bup * mu; bdn = bdn * md;
                    f32x4 R[4], O[4];
#pragma unroll
                    for (int m = 0; m < 4; ++m) R[m] = acc[ai][bj][m][n];
#pragma unroll
                    for (int m = 0; m < 4; ++m) { const f32x4 pv = m > 0 ? R[m - 1] : bup, nx = m < 3 ? R[m + 1] : bdn; f32x4 up, dn;
#pragma unroll
                        for (int e = 0; e < 4; ++e) {
                            up[e] = __builtin_bit_cast(float, __builtin_amdgcn_mov_dpp(__builtin_bit_cast(int, fr == 15 ? pv[e] : R[m][e]), 0x121  , 0xf, 0xf, false));
                            dn[e] = __builtin_bit_cast(float, __builtin_amdgcn_mov_dpp(__builtin_bit_cast(int, fr == 0 ? nx[e] : R[m][e]), 0x12f  , 0xf, 0xf, false)); }
                        O[m] = __builtin_elementwise_fma(w0, up, __builtin_elementwise_fma(w1, R[m], __builtin_elementwise_fma(w2, dn, bb))); }
#pragma unroll
                    for (int m = 0; m < 4; ++m) acc[ai][bj][m][n] = O[m];
            }
            asm volatile("" ::: "memory"); }
#undef EPI_LOADW
#pragma unroll
        for (int ai = 0; ai < 2; ++ai)
#pragma unroll
            for (int m = 0; m < 4; ++m) { const f32x4 g0 = acc[ai][0][m][0], g1 = acc[ai][0][m][1], v0 = acc[ai][1][m][0], v1 = acc[ai][1][m][1];
                u32x4 w; w.x = cvt_pk_bf16(silu_f(g0[0]) * v0[0], silu_f(g0[1]) * v0[1]); w.y = cvt_pk_bf16(silu_f(g0[2]) * v0[2], silu_f(g0[3]) * v0[3]);
                w.z = cvt_pk_bf16(silu_f(g1[0]) * v1[0], silu_f(g1[1]) * v1[1]); w.w = cvt_pk_bf16(silu_f(g1[2]) * v1[2], silu_f(g1[3]) * v1[3]);
                *(u32x4*)(ACT + (size_t)(u.pm * BM + ai * HALF + wr * 64 + m * 16 + fr) * DFF + gcol) = w; }
    }
};
struct EpiResid {
    static constexpr bool PERM = false, AFTER_DRAIN = false;
    float* X; const float* gate; float* part; const float* xin_lat; const float* xin_ctx;
    __device__ __forceinline__ void operator()(const f32x4 (&acc)[2][2][4][2], const Unit& u, int wr, int wc, int fr_, int fq_) const {
        int fr = fr_, fq = fq_; asm volatile("" : "+v"(fr), "+v"(fq));
        const int bb = u.pm / 9, r = (u.pm - bb * 9 == 0) ? 4 : bb;
        const int col0 = u.pn * BM + wc * 32 + 4 * fq;
        const float* g = gate + (size_t)r * NMOD6 + col0;
        f32x4 gv[2][2];
#pragma unroll
        for (int bj = 0; bj < 2; ++bj)
#pragma unroll
            for (int n = 0; n < 2; ++n) gv[bj][n] = *(const f32x4*)(g + bj * HALF + n * 16);
        if (u.atomic) {
#pragma unroll
            for (int ai = 0; ai < 2; ++ai)
#pragma unroll
                for (int m = 0; m < 4; ++m)
#pragma unroll
                    for (int bj = 0; bj < 2; ++bj)
#pragma unroll
                        for (int n = 0; n < 2; ++n) *(f32x4*)(part + ((size_t)(u.ks * 1024 + bb * 256 + ai * HALF + wr * 64 + m * 16 + fr)) * DM + col0 + bj * HALF + n * 16) = acc[ai][bj][m][n];
            return;
        }
        const int jt = u.pm - bb * 9;
#pragma unroll
        for (int ai = 0; ai < 2; ++ai) {
            f32x4 xv[4][2][2];
#pragma unroll
            for (int m = 0; m < 4; ++m) { const int rr = ai * HALF + wr * 64 + m * 16 + fr;
                const float* xs = X + (size_t)(u.pm * BM + rr) * DM + col0;
                if (jt == 0) { if (xin_ctx) xs = xin_ctx + ((size_t)bb * CTX + rr) * DM + col0; } else { if (xin_lat) xs = xin_lat + ((size_t)bb * SEQ + (jt - 1) * 256 + rr) * DM + col0; }
#pragma unroll
                for (int bj = 0; bj < 2; ++bj)
#pragma unroll
                    for (int n = 0; n < 2; ++n) xv[m][bj][n] = *(const f32x4*)(xs + bj * HALF + n * 16); }
            asm volatile("" ::: "memory");
#pragma unroll
            for (int m = 0; m < 4; ++m) { float* xp = X + (size_t)(u.pm * BM + ai * HALF + wr * 64 + m * 16 + fr) * DM + col0;
#pragma unroll
                for (int bj = 0; bj < 2; ++bj)
#pragma unroll
                    for (int n = 0; n < 2; ++n) *(f32x4*)(xp + bj * HALF + n * 16) = xv[m][bj][n] + gv[bj][n] * acc[ai][bj][m][n]; }
            asm volatile("" ::: "memory");
        }
    }
};

template <class Epi, class Sched, bool ALIGN_EPI = false, bool SP2 = false>
__device__ __forceinline__ void gemm_phase(LAS unsigned char* lds, const Gemm g, const Sched& S, const Epi& E, const int tid) {
    const int wid = __builtin_amdgcn_readfirstlane(tid >> 6), lane = tid & 63, wr = wid >> 2, wc = wid & 3, fr = lane & 15, fq = lane >> 4;
    const int K = g.K;
    unsigned voffA[2], voffB[2];
#pragma unroll
    for (int i = 0; i < 2; ++i) { int R, C; stage_rc(tid * 16 + i * 8192, R, C); const int Rb = Epi::PERM ? ((R & ~31) + perm32(R & 31)) : R;
        voffA[i] = (unsigned)(R * K + C) * 2u; voffB[i] = (unsigned)(Rb * K + C) * 2u; }
    const size_t kstep = (size_t)(BK * 2);
    const size_t hstep = (size_t)HALF * K * 2;
    const size_t tstep = 2 * hstep;
    const unsigned ldsw = (unsigned)wid * 1024u;
    const int aoff = lds_byte(wr * 64 + fr, fq * 8), boff = lds_byte(wc * 32 + fr, fq * 8);
#define PG8_SA(b, h) (((b) * 2 + (h)) * HTB)
#define PG8_SB(b, h) ((4 + (b) * 2 + (h)) * HTB)
#define PG8_STAGE(bufoff, gbase, voff) do { _Pragma("unroll") for (int _i = 0; _i < 2; ++_i) \
        __builtin_amdgcn_global_load_lds((const unsigned*)((const char*)(gbase) + (voff)[_i]), (LAS unsigned*)(lds + (bufoff) + ldsw + _i * 8192), 16, 0, 0); } while (0)
#define PG8_LDA(dst, b, h) do { _Pragma("unroll") for (int m = 0; m < 4; ++m) _Pragma("unroll") for (int k = 0; k < 2; ++k) dst[m][k] = *(const LAS bf16x8*)(lds + PG8_SA(b, h) + aoff + m * 2048 + k * 1024); } while (0)
#define PG8_LDB(dst, b, h) do { _Pragma("unroll") for (int n = 0; n < 2; ++n) _Pragma("unroll") for (int k = 0; k < 2; ++k) dst[n][k] = *(const LAS bf16x8*)(lds + PG8_SB(b, h) + boff + n * 2048 + k * 1024); } while (0)
#define PG8_MMA(ai, bj, At, Bt) do { __builtin_amdgcn_s_setprio(1); _Pragma("unroll") for (int m = 0; m < 4; ++m) _Pragma("unroll") for (int n = 0; n < 2; ++n) _Pragma("unroll") for (int k = 0; k < 2; ++k) \
        acc[ai][bj][m][n] = __builtin_amdgcn_mfma_f32_16x16x32_bf16(Bt[n][k], At[m][k], acc[ai][bj][m][n], 0, 0, 0); __builtin_amdgcn_s_setprio(0); } while (0)
#define PG8_WAIT_V(n) asm volatile("s_waitcnt vmcnt(" #n ")" ::: "memory")
#define PG8_WAIT_L(n) asm volatile("s_waitcnt lgkmcnt(" #n ")" ::: "memory")
#define PG8_BAR __builtin_amdgcn_s_barrier()
#define PG8_SCHED __builtin_amdgcn_sched_barrier(0)
    Unit cur, nxt; int ui = 0;
    if (!S.next(0, cur)) return;
    f32x4 acc[2][2][4][2];
#pragma unroll
    for (int a = 0; a < 2; ++a)
#pragma unroll
        for (int b = 0; b < 2; ++b)
#pragma unroll
            for (int m = 0; m < 4; ++m)
#pragma unroll
                for (int n = 0; n < 2; ++n) acc[a][b][m][n] = (f32x4){0.f, 0.f, 0.f, 0.f};
    bf16x8 At[4][2], B0[2][2], B1[2][2];
    const char* cA = (const char*)g.A + (size_t)cur.pm * tstep + (size_t)cur.kt0 * kstep; const char* cB = (const char*)g.Bt + (size_t)cur.pn * tstep + (size_t)cur.kt0 * kstep;
    S.a_ready(cur);
    if constexpr (SP2) {
        PG8_STAGE(PG8_SB(0, 0), cB, voffB); PG8_STAGE(PG8_SB(0, 1), cB + hstep, voffB); PG8_STAGE(PG8_SA(0, 0), cA, voffA); PG8_STAGE(PG8_SA(0, 1), cA + hstep, voffA);
        if (wr == 1) PG8_BAR;
        PG8_WAIT_V(2); PG8_BAR;
        PG8_STAGE(PG8_SB(1, 0), cB + kstep, voffB); PG8_STAGE(PG8_SA(1, 0), cA + kstep, voffA); PG8_STAGE(PG8_SB(1, 1), cB + hstep + kstep, voffB);
        PG8_WAIT_V(6); PG8_BAR;
    } else {
        PG8_STAGE(PG8_SB(0, 0), cB, voffB); PG8_STAGE(PG8_SA(0, 0), cA, voffA); PG8_STAGE(PG8_SB(0, 1), cB + hstep, voffB); PG8_STAGE(PG8_SA(0, 1), cA + hstep, voffA);
        if (wr == 1) PG8_BAR;
        PG8_WAIT_V(4); PG8_BAR;
        PG8_STAGE(PG8_SB(1, 0), cB + kstep, voffB); PG8_STAGE(PG8_SA(1, 0), cA + kstep, voffA); PG8_STAGE(PG8_SB(1, 1), cB + hstep + kstep, voffB);
        PG8_WAIT_V(6); PG8_BAR;
    }
    for (;;) {
        const bool has_next = S.next(ui + 1, nxt);
        const char* nA = has_next ? (const char*)g.A + (size_t)nxt.pm * tstep + (size_t)nxt.kt0 * kstep : cA; const char* nB = has_next ? (const char*)g.Bt + (size_t)nxt.pn * tstep + (size_t)nxt.kt0 * kstep : cB;
        const int nt = cur.ktn;
        for (int t = 0; t < nt; t += 2) {
            const bool last = (t == nt - 2);
            const char* a1 = cA + (size_t)(t + 1) * kstep;
            const char* a2 = last ? nA : cA + (size_t)(t + 2) * kstep; const char* b2 = last ? nB : cB + (size_t)(t + 2) * kstep;
            const char* a3 = a2 + kstep; const char* b3 = b2 + kstep;
            if (last && has_next) S.a_ready(nxt);
            if constexpr (SP2) {
            PG8_LDB(B0, 0, 0); PG8_LDB(B1, 0, 1); PG8_SCHED; PG8_LDA(At, 0, 0); PG8_STAGE(PG8_SA(1, 1), a1 + hstep, voffA);
            PG8_WAIT_V(8); PG8_WAIT_L(0); PG8_BAR; PG8_MMA(0, 0, At, B0); PG8_MMA(0, 1, At, B1); PG8_BAR; PG8_SCHED;
            PG8_LDA(At, 0, 1); PG8_STAGE(PG8_SB(0, 0), b2, voffB); PG8_STAGE(PG8_SB(0, 1), b2 + hstep, voffB); PG8_STAGE(PG8_SA(0, 0), a2, voffA);
            PG8_WAIT_V(8); PG8_WAIT_L(0); PG8_BAR; PG8_MMA(1, 0, At, B0); PG8_MMA(1, 1, At, B1); PG8_BAR; PG8_SCHED;
            PG8_LDB(B0, 1, 0); PG8_LDB(B1, 1, 1); PG8_SCHED; PG8_LDA(At, 1, 0); PG8_STAGE(PG8_SA(0, 1), a2 + hstep, voffA);
            PG8_WAIT_V(8); PG8_WAIT_L(0); PG8_BAR; PG8_MMA(0, 0, At, B0); PG8_MMA(0, 1, At, B1); PG8_BAR; PG8_SCHED;
            PG8_LDA(At, 1, 1); PG8_STAGE(PG8_SB(1, 0), b3, voffB); PG8_STAGE(PG8_SB(1, 1), b3 + hstep, voffB); PG8_STAGE(PG8_SA(1, 0), a3, voffA);
            PG8_WAIT_V(8); PG8_WAIT_L(0); PG8_BAR; PG8_MMA(1, 0, At, B0); PG8_MMA(1, 1, At, B1); PG8_BAR; PG8_SCHED;
            } else {
            PG8_LDB(B0, 0, 0); PG8_SCHED; PG8_LDA(At, 0, 0); PG8_STAGE(PG8_SA(1, 1), a1 + hstep, voffA);
            PG8_WAIT_L(8); PG8_BAR; PG8_WAIT_L(0); PG8_MMA(0, 0, At, B0); PG8_BAR; PG8_SCHED;
            PG8_LDB(B1, 0, 1); PG8_STAGE(PG8_SB(0, 0), b2, voffB);
            PG8_BAR; PG8_WAIT_L(0); PG8_MMA(0, 1, At, B1); PG8_BAR;
            PG8_LDA(At, 0, 1); PG8_STAGE(PG8_SA(0, 0), a2, voffA);
            PG8_BAR; PG8_WAIT_L(0); PG8_MMA(1, 0, At, B0); PG8_BAR; PG8_SCHED;
            PG8_STAGE(PG8_SB(0, 1), b2 + hstep, voffB);
            PG8_WAIT_V(6); PG8_BAR; PG8_MMA(1, 1, At, B1); PG8_BAR;
            PG8_LDB(B0, 1, 0); PG8_SCHED; PG8_LDA(At, 1, 0); PG8_STAGE(PG8_SA(0, 1), a2 + hstep, voffA);
            PG8_WAIT_L(8); PG8_BAR; PG8_WAIT_L(0); PG8_MMA(0, 0, At, B0); PG8_BAR; PG8_SCHED;
            PG8_LDB(B1, 1, 1); PG8_STAGE(PG8_SB(1, 0), b3, voffB);
            PG8_BAR; PG8_WAIT_L(0); PG8_MMA(0, 1, At, B1); PG8_BAR;
            PG8_LDA(At, 1, 1); PG8_STAGE(PG8_SA(1, 0), a3, voffA);
            PG8_BAR; PG8_WAIT_L(0); PG8_MMA(1, 0, At, B0); PG8_BAR; PG8_SCHED;
            PG8_STAGE(PG8_SB(1, 1), b3 + hstep, voffB);
            PG8_WAIT_V(6); PG8_BAR; PG8_MMA(1, 1, At, B1); PG8_BAR;
            }
        }
        if constexpr (ALIGN_EPI) { if (wr == 0) PG8_BAR; }
        if constexpr (!Epi::AFTER_DRAIN) { E(acc, cur, wr, wc, fr, fq); S.done(cur); }
        if (!has_next) break;
#pragma unroll
        for (int a = 0; a < 2; ++a)
#pragma unroll
            for (int b = 0; b < 2; ++b)
#pragma unroll
                for (int m = 0; m < 4; ++m)
#pragma unroll
                    for (int n = 0; n < 2; ++n) acc[a][b][m][n] = (f32x4){0.f, 0.f, 0.f, 0.f};
        cur = nxt; cA = nA; cB = nB; ++ui;
        if constexpr (ALIGN_EPI) { if (wr == 1) PG8_BAR; }
    }
    PG8_WAIT_V(0);
    if constexpr (!ALIGN_EPI) { if (wr == 0) PG8_BAR; }
    PG8_BAR;
#undef PG8_SA
#undef PG8_SB
#undef PG8_STAGE
#undef PG8_LDA
#undef PG8_LDB
#undef PG8_MMA
#undef PG8_WAIT_V
#undef PG8_WAIT_L
#undef PG8_BAR
#undef PG8_SCHED
}
}

namespace att {
constexpr int NW = 8, QBLK = 32, KVBLK = 64, LDP = INC  , LDO = 768;
constexpr float THR = 8.f;
constexpr int SHM_V = KVBLK * 128 * 2;
#define SBAR() __builtin_amdgcn_sched_barrier(0)
__device__ __forceinline__ int crow(int r, int hi) { return (r & 3) + 8 * (r >> 2) + 4 * hi; }
template <int DK> __device__ __forceinline__ int kswz(int row, int colB) { return row * (DK * 2) + (colB ^ ((row & 7) << 4)); }

template <int DK> __device__ __forceinline__ void partialSM(f32x16& p0, f32x16& p1, float& m_reg, float& mn, float& alpha) {
  constexpr float SCALE = (DK == 128) ? 0.088388347648318440f : 0.125f;
  constexpr float C = SCALE * 1.4426950408889634f;
  float pmax = p0[0];
#pragma unroll
  for (int r = 1; r < 16; ++r) pmax = fmaxf(pmax, p0[r]);
#pragma unroll
  for (int r = 0; r < 16; ++r) pmax = fmaxf(pmax, p1[r]);
  { auto rr = __builtin_amdgcn_permlane32_swap(__float_as_uint(pmax), __float_as_uint(pmax), false, false);
    pmax = fmaxf(__uint_as_float(rr[0]), __uint_as_float(rr[1])); }
  if (__builtin_expect(__all(pmax - m_reg <= THR / SCALE), 1)) { mn = m_reg; alpha = 1.f; }
  else { mn = fmaxf(m_reg, pmax); alpha = __builtin_amdgcn_exp2f((m_reg - mn) * C); m_reg = mn; }
  float mnC = -mn * C;
#pragma unroll
  for (int r = 0; r < 16; ++r) p0[r] = fmaf(p0[r], C, mnC);
#pragma unroll
  for (int r = 0; r < 16; ++r) p1[r] = fmaf(p1[r], C, mnC);
#pragma unroll
  for (int r = 0; r < 16; ++r) p0[r] = __builtin_amdgcn_exp2f(p0[r]);
}
__device__ __forceinline__ void finishSM(f32x16& p0, f32x16& p1, float alpha, float& l_reg, bf16x8& pa0, bf16x8& pa1, bf16x8& pa2, bf16x8& pa3) {
#pragma unroll
  for (int r = 0; r < 16; ++r) p1[r] = __builtin_amdgcn_exp2f(p1[r]);
  float ps = 0;
#pragma unroll
  for (int r = 0; r < 16; ++r) ps += p0[r];
#pragma unroll
  for (int r = 0; r < 16; ++r) ps += p1[r];
  { auto rr = __builtin_amdgcn_permlane32_swap(__float_as_uint(ps), __float_as_uint(ps), false, false);
    ps = __uint_as_float(rr[0]) + __uint_as_float(rr[1]); }
  l_reg = l_reg * alpha + ps;
#define PK4(P, BASE, OUT) do { unsigned a0 = cvt_pk_bf16(P[BASE + 0], P[BASE + 1]), a1 = cvt_pk_bf16(P[BASE + 2], P[BASE + 3]);   \
    unsigned b0 = cvt_pk_bf16(P[BASE + 4], P[BASE + 5]), b1 = cvt_pk_bf16(P[BASE + 6], P[BASE + 7]);                              \
    auto r0 = __builtin_amdgcn_permlane32_swap(a0, b0, false, false); auto r1 = __builtin_amdgcn_permlane32_swap(a1, b1, false, false); \
    u32x4 w = {r0[0], r1[0], r0[1], r1[1]}; OUT = *reinterpret_cast<bf16x8*>(&w); } while (0)
  PK4(p0, 0, pa0); PK4(p0, 8, pa1); PK4(p1, 0, pa2); PK4(p1, 8, pa3);
#undef PK4
}
template <int DK> __device__ __forceinline__ void qkt(f32x16& p0, f32x16& p1, const char* Ks, const bf16x8* qr, int r32, int hi) {
  p0 = f32x16{}; p1 = f32x16{};
#pragma unroll
  for (int d0 = 0; d0 < DK / 16; ++d0) { int cb = (d0 * 16 + hi * 8) * 2;
    bf16x8 b0 = *reinterpret_cast<const bf16x8*>(Ks + kswz<DK>(r32, cb));
    bf16x8 b1 = *reinterpret_cast<const bf16x8*>(Ks + kswz<DK>(32 + r32, cb));
    p0 = __builtin_amdgcn_mfma_f32_32x32x16_bf16(b0, qr[d0], p0, 0, 0, 0);
    p1 = __builtin_amdgcn_mfma_f32_32x32x16_bf16(b1, qr[d0], p1, 0, 0, 0); }
}
__device__ __forceinline__ int v_st(int k, int c) { const int kk = (k & ~0xC) | ((k & 4) << 1) | ((k & 8) >> 1); return ((kk >> 3) * 4 + (c >> 5)) * 512 + ((kk & 7) * 32 + (c & 31)) * 2; }
__device__ __forceinline__ int v_rd_base(int lane) { return ((lane & 3) << 3) | (((lane >> 2) & 3) << 6) | (((lane >> 4) & 1) << 5) | (((lane >> 5) & 1) << 8); }
constexpr int v_rd_off(int d0, int ks, int half) { return d0 * 512 + ks * 4096 + half * 2048; }
template <int OFF> __device__ __forceinline__ s16x4 tr_read(int vb) {
  s16x4 r; asm volatile("ds_read_b64_tr_b16 %0, %1 offset:%2" : "=&v"(r) : "v"(vb), "i"(OFF) : "memory"); return r;
}
template <int D0> __device__ __forceinline__ void pv_one(f32x16& od, int vb, bf16x8 pa0, bf16x8 pa1, bf16x8 pa2, bf16x8 pa3) {
  const s16x4 l0 = tr_read<v_rd_off(D0, 0, 0)>(vb), h0 = tr_read<v_rd_off(D0, 0, 1)>(vb), l1 = tr_read<v_rd_off(D0, 1, 0)>(vb), h1 = tr_read<v_rd_off(D0, 1, 1)>(vb);
  const s16x4 l2 = tr_read<v_rd_off(D0, 2, 0)>(vb), h2 = tr_read<v_rd_off(D0, 2, 1)>(vb), l3 = tr_read<v_rd_off(D0, 3, 0)>(vb), h3 = tr_read<v_rd_off(D0, 3, 1)>(vb);
  asm volatile("s_waitcnt lgkmcnt(0)" ::: "memory"); SBAR();
#define PK(L, H) (bf16x8){L[0], L[1], L[2], L[3], H[0], H[1], H[2], H[3]}
  od = __builtin_amdgcn_mfma_f32_32x32x16_bf16(pa0, PK(l0, h0), od, 0, 0, 0);
  od = __builtin_amdgcn_mfma_f32_32x32x16_bf16(pa1, PK(l1, h1), od, 0, 0, 0);
  od = __builtin_amdgcn_mfma_f32_32x32x16_bf16(pa2, PK(l2, h2), od, 0, 0, 0);
  od = __builtin_amdgcn_mfma_f32_32x32x16_bf16(pa3, PK(l3, h3), od, 0, 0, 0);
#undef PK
}
__device__ __forceinline__ void pv_d0(f32x16* o, int vb, bf16x8 pa0, bf16x8 pa1, bf16x8 pa2, bf16x8 pa3) {
  pv_one<0>(o[0], vb, pa0, pa1, pa2, pa3); pv_one<1>(o[1], vb, pa0, pa1, pa2, pa3); pv_one<2>(o[2], vb, pa0, pa1, pa2, pa3); pv_one<3>(o[3], vb, pa0, pa1, pa2, pa3);
}

template <int DK>
__device__ __forceinline__ void attn_unit(const bf16_t* __restrict__ Qb, const bf16_t* __restrict__ Kh, const bf16_t* __restrict__ Vh,
                                          float* __restrict__ Ob, int seq, char* lds, const int tid) {
  constexpr int SHM_K = KVBLK * DK * 2;
  const int wid = tid >> 6, lane = tid & 63, r32 = lane & 31, hi = lane >> 5;
  char* V_lds = lds; char* K_lds = lds + 2 * SHM_V;
  float* ws = (float*)(lds + 2 * SHM_V + 2 * SHM_K) + wid * 64; float* li_l = ws; float* al_l = ws + 32;
  float m_reg = -1e30f, l_reg = 0; f32x16 o[4] = {}; bf16x8 qr[DK / 16];
  const bf16_t* Qw = Qb + (long)(wid * QBLK + r32) * LDP + hi * 8;
#pragma unroll
  for (int d0 = 0; d0 < DK / 16; ++d0) qr[d0] = *reinterpret_cast<const bf16x8*>(Qw + d0 * 16);
  const int sr = tid >> 4, sc = (tid & 15) * 8, vst0 = v_st(sr, sc), vst1 = v_st(32 + sr, sc);
  const int ksr = (DK == 128) ? sr : (tid >> 3), ksc = (DK == 128) ? sc : ((tid & 7) * 8);
  const int vb0 = (int)(uintptr_t)V_lds + v_rd_base(lane);
  struct { bf16x8 vs0, vs1, ks0, ks1; } sr_[2];
#define SLOAD(i, k0) do { sr_[i].vs0 = *reinterpret_cast<const bf16x8*>(&Vh[(long)((k0) + sr) * LDP + sc]); sr_[i].vs1 = *reinterpret_cast<const bf16x8*>(&Vh[(long)((k0) + 32 + sr) * LDP + sc]); \
    sr_[i].ks0 = *reinterpret_cast<const bf16x8*>(&Kh[(long)((k0) + ksr) * LDP + ksc]); if constexpr (DK == 128) sr_[i].ks1 = *reinterpret_cast<const bf16x8*>(&Kh[(long)((k0) + 32 + ksr) * LDP + ksc]); } while (0)
#define SWRITE(b, i) do { *(bf16x8*)(V_lds + (b) * SHM_V + vst0) = sr_[i].vs0;          \
    *(bf16x8*)(V_lds + (b) * SHM_V + vst1) = sr_[i].vs1; int kc = ksc * 2;               \
    *(bf16x8*)(K_lds + (b) * SHM_K + kswz<DK>(ksr, kc)) = sr_[i].ks0;                       \
    if constexpr (DK == 128) *(bf16x8*)(K_lds + (b) * SHM_K + kswz<DK>(32 + ksr, kc)) = sr_[i].ks1; } while (0)
#define SWAIT() do { if constexpr (DK == 128) asm volatile("s_waitcnt vmcnt(4)" ::: "memory"); else asm volatile("s_waitcnt vmcnt(3)" ::: "memory"); } while (0)
#define RESC(a) do { if (__any((a) < 1.f)) { if (hi == 0) al_l[r32] = (a); asm volatile("s_waitcnt lgkmcnt(0)" ::: "memory"); \
    _Pragma("unroll") for (int d = 0; d < 4; ++d) _Pragma("unroll") for (int r = 0; r < 16; ++r) o[d][r] *= al_l[crow(r, hi)]; } } while (0)
  f32x16 pA0, pA1, pB0, pB1; float mnA, mnB, alA, alB; bf16x8 pa0, pa1, pa2, pa3; const int NT = seq / KVBLK;
  constexpr int SE = 0, SO = 1;
  SLOAD(SE, 0); asm volatile("s_waitcnt vmcnt(0)" ::: "memory"); SWRITE(0, SE); __syncthreads();
  qkt<DK>(pA0, pA1, K_lds, qr, r32, hi); partialSM<DK>(pA0, pA1, m_reg, mnA, alA);
  SLOAD(SO, KVBLK); if (2 < NT) SLOAD(SE, 2 * KVBLK);
  SWAIT(); SWRITE(1, SO); __syncthreads();
  for (int j = 1; j + 1 < NT; j += 2) {
    SBAR(); qkt<DK>(pB0, pB1, K_lds + SHM_K, qr, r32, hi);
    finishSM(pA0, pA1, alA, l_reg, pa0, pa1, pa2, pa3); SBAR();
    SLOAD(SO, (j + 2) * KVBLK); SBAR();
    pv_d0(o, vb0, pa0, pa1, pa2, pa3); partialSM<DK>(pB0, pB1, m_reg, mnB, alB);
    __syncthreads(); SWAIT(); SWRITE(0, SE);
    RESC(alB); __syncthreads();
    SBAR(); qkt<DK>(pA0, pA1, K_lds, qr, r32, hi);
    finishSM(pB0, pB1, alB, l_reg, pa0, pa1, pa2, pa3); SBAR();
    if (j + 3 < NT) SLOAD(SE, (j + 3) * KVBLK); SBAR();
    pv_d0(o, vb0 + (int)SHM_V, pa0, pa1, pa2, pa3); partialSM<DK>(pA0, pA1, m_reg, mnA, alA);
    __syncthreads(); SWAIT(); SWRITE(1, SO);
    RESC(alA); __syncthreads();
  }
  SBAR(); qkt<DK>(pB0, pB1, K_lds + SHM_K, qr, r32, hi);
  finishSM(pA0, pA1, alA, l_reg, pa0, pa1, pa2, pa3); SBAR();
  pv_d0(o, vb0, pa0, pa1, pa2, pa3); partialSM<DK>(pB0, pB1, m_reg, mnB, alB);
  __syncthreads(); RESC(alB);
  finishSM(pB0, pB1, alB, l_reg, pa0, pa1, pa2, pa3); SBAR();
  pv_d0(o, vb0 + (int)SHM_V, pa0, pa1, pa2, pa3);
  if (hi == 0) li_l[r32] = l_reg; asm volatile("s_waitcnt lgkmcnt(0)" ::: "memory");
  float rli[16];
#pragma unroll
  for (int r = 0; r < 16; ++r) rli[r] = __builtin_amdgcn_rcpf(li_l[crow(r, hi)]);
  float* Ow = Ob + (long)(wid * QBLK) * LDO;
#pragma unroll
  for (int r = 0; r < 16; ++r) { int orow = crow(r, hi);
#pragma unroll
    for (int d0 = 0; d0 < 4; ++d0) Ow[(long)orow * LDO + d0 * 32 + r32] = o[d0][r] * rli[r]; }
  __syncthreads();
#undef SLOAD
#undef SWRITE
#undef SWAIT
#undef RESC
}
}


#define XB_TMO      128
#define XB_XCNT(j)  (256  + 64 * (j))
#define XB_XSUB(j)  (1280 + 64 * (j))
#define XB_XGEN(j)  (2304 + 64 * (j))
#define XB_TOP      3328
#define XB_TOPGEN   3392
#define XCD_BAR_WORDS 3456
#define XB_SPIN_CAP (1u << 22)
__device__ __forceinline__ unsigned xb_ld(unsigned* p)              { return __hip_atomic_load(p, __ATOMIC_RELAXED, __HIP_MEMORY_SCOPE_AGENT); }
__device__ __forceinline__ unsigned xb_add(unsigned* p, unsigned v) { return __hip_atomic_fetch_add(p, v, __ATOMIC_RELAXED, __HIP_MEMORY_SCOPE_AGENT); }
__device__ __forceinline__ unsigned xb_xcc_id() { return (unsigned)__builtin_amdgcn_s_getreg((3 << 11) | 20) & 0xFu; }
#define XB_SPIN(cond, bar) do { unsigned _sp = 0; while (cond) { __builtin_amdgcn_s_sleep(1); \
    if ((++_sp & 255u) == 0u) { if (xb_ld(&(bar)[XB_TMO])) break; if (_sp > XB_SPIN_CAP) { atomicAdd(&(bar)[XB_TMO], 1u); break; } } } } while (0)
struct XcdBarrier { unsigned* bar; unsigned x; volatile LAS unsigned* st; };
__device__ __forceinline__ XcdBarrier xcd_barrier_post(unsigned* bar, volatile LAS unsigned* st) {
    XcdBarrier b; b.bar = bar; b.x = xb_xcc_id(); b.st = st;
    if (threadIdx.x == 0) (void)xb_add(&bar[XB_XCNT(b.x)], 1u);
    return b;
}
__device__ __forceinline__ void xcd_barrier_complete(unsigned* bar, unsigned x, unsigned& nloc, unsigned& nx) {
    const unsigned G = gridDim.x * gridDim.y * gridDim.z;
    unsigned sum, cnt, mine, sp = 0u;
    for (;;) {
        sum = 0u; cnt = 0u; mine = 0u;
#pragma unroll
        for (unsigned j = 0; j < 16; ++j) { const unsigned c = xb_ld(&bar[XB_XCNT(j)]); sum += c; cnt += (c > 0u) ? 1u : 0u; mine = (j == x) ? c : mine; }
        if (sum == G) break;
        __builtin_amdgcn_s_sleep(1);
        if ((++sp & 255u) == 0u) { if (xb_ld(&bar[XB_TMO])) break; if (sp > XB_SPIN_CAP) { atomicAdd(&bar[XB_TMO], 1u); break; } }
    }
    nloc = mine > 0u ? mine : 1u; nx = cnt > 0u ? cnt : 1u;
}
__device__ __forceinline__ void xcd_barrier(const XcdBarrier& b) {
    asm volatile("s_waitcnt vmcnt(0)" ::: "memory");
    __syncthreads();
    if (threadIdx.x == 0) {
        unsigned* bar = b.bar; unsigned bx = b.x; asm volatile("" : "+s"(bar), "+s"(bx));
        __builtin_amdgcn_s_waitcnt(0);
        unsigned nloc = b.st[0], nx = b.st[1];
        if (nloc == 0u) { xcd_barrier_complete(bar, bx, nloc, nx); b.st[0] = nloc; b.st[1] = nx; }
        const unsigned old = xb_add(&bar[XB_XSUB(bx)], 1u);
        const unsigned gen = old / nloc;
        if (old + 1u == (gen + 1u) * nloc) {
            __builtin_amdgcn_fence(__ATOMIC_RELEASE, "agent");
            asm volatile("s_waitcnt vmcnt(0)" ::: "memory");
            const unsigned og = xb_add(&bar[XB_TOP], 1u);
            const unsigned tg = og / nx;
            if (og + 1u == (tg + 1u) * nx) xb_add(&bar[XB_TOPGEN], 1u);
            else XB_SPIN(xb_ld(&bar[XB_TOPGEN]) == tg, bar);
            __builtin_amdgcn_fence(__ATOMIC_ACQUIRE, "agent");
            xb_add(&bar[XB_XGEN(bx)], 1u);
            asm volatile("s_waitcnt vmcnt(0)" ::: "memory");
        } else {
            XB_SPIN(xb_ld(&bar[XB_XGEN(bx)]) == gen, bar);
            __builtin_amdgcn_fence(__ATOMIC_ACQUIRE, "agent");
            asm volatile("s_waitcnt vmcnt(0)" ::: "memory");
        }
    }
    __syncthreads();
}


#ifndef DBG_STOP
#define DBG_STOP 0
#endif
constexpr size_t OUTN = (size_t)NB * SEQ * DM;
__device__ __forceinline__ void dbg_dump_f32(float* out, const float* src, size_t n, int gtid, int gn) {
    for (size_t i = gtid; i < OUTN; i += gn) { float s = 0.f; for (size_t k = i; k < n; k += OUTN) s += src[k]; out[i] = s; } }
__device__ __forceinline__ void dbg_dump_bf16(float* out, const bf16_t* src, size_t n, int gtid, int gn) {
    for (size_t i = gtid; i < OUTN; i += gn) { float s = 0.f; for (size_t k = i; k < n; k += OUTN) s += __uint_as_float((unsigned)src[k] << 16); out[i] = s; } }
#define DBG_AT(N, CALL) do { if (p.dbg == (N) && l == 0) { const int gtid = blockIdx.x * 512 + threadIdx.x, gn = gridDim.x * 512; CALL; return; } } while (0)

struct Params { const float* in[25]; float* out; unsigned char* ws; int dbg, pad; };
enum { I_X = 0, I_C, I_CTX, I_CCTX, I_WMOD, I_BMOD, I_NMIX, I_NFFN, I_WIN, I_LQ1, I_LK1, I_LQ2, I_LK2, I_SUBLN, I_QN, I_KN, I_POOLW, I_POOLS, I_GON, I_WOUT, I_WUP, I_CONVW, I_CONVB, I_WDN, I_FN };

constexpr int LDS_BYTES = 147456;

template <int MODE>
__device__ __forceinline__ void transpose_item(const float* W, int K, int N, bf16_t* WT, LAS float* scr, int item, int lane,
                                               const float* subln, const float* pools, const float* gon, float one_m_li) {
    const int nblk = N / 32, kb = item / nblk, nb = item % nblk, k0 = 64 * kb, n0 = 32 * nb;
    float wv[32];
#pragma unroll
    for (int i = 0; i < 32; ++i) { const int kk = 2 * i + (lane >> 5); wv[i] = W[(size_t)(k0 + kk) * N + n0 + (lane & 31)]; }
#pragma unroll
    for (int i = 0; i < 32; ++i) { const int kk = 2 * i + (lane >> 5); float w = wv[i];
        if (MODE == 1) { const int k = k0 + kk; const float s = (k < 768) ? subln[k & 127] * one_m_li : ((k < 1280) ? pools[k - 768] : gon[k - 1280]); w *= s; }
        scr[kk * 33 + (lane & 31)] = w; }
    asm volatile("s_waitcnt lgkmcnt(0)" ::: "memory");
    const int c = lane & 7;
#pragma unroll
    for (int j = 0; j < 4; ++j) { const int n = (lane >> 3) + 8 * j; const LAS float* s = scr + (8 * c) * 33 + n;
        u32x4 o; o.x = cvt_pk_bf16(s[0 * 33], s[1 * 33]); o.y = cvt_pk_bf16(s[2 * 33], s[3 * 33]); o.z = cvt_pk_bf16(s[4 * 33], s[5 * 33]); o.w = cvt_pk_bf16(s[6 * 33], s[7 * 33]);
        int nd = n0 + n; if (MODE == 2) { const int half = n0 >= DFF ? 1 : 0, rem = n0 - half * DFF; nd = (rem >> 7) * 256 + half * 128 + (rem & 127) + n; }
        *(u32x4*)(WT + (size_t)nd * K + k0 + 8 * c) = o; }
    asm volatile("s_waitcnt lgkmcnt(0)" ::: "memory");
}

template <int MODE>
__device__ __forceinline__ void transpose_matrix(const float* W, int K, int N, bf16_t* WT, LAS float* scr, int lane, int worker, int nworkers,
                                                 const float* subln, const float* pools, const float* gon, float one_m_li) {
    const int items = (K / 64) * (N / 32);
    for (int it = worker; it < items; it += nworkers) transpose_item<MODE>(W, K, N, WT, scr, it, lane, subln, pools, gon, one_m_li);
}
#define CONVERT_OUT_UP_DOWN(l_, worker_, nworkers_) do { const int l__ = (l_); const float li__ = l__ == 0 ? 0.2f : 0.35550906759f; LAS float* scr__ = (LAS float*)(L + wave * 8704); \
    transpose_matrix<1>(p.in[I_WOUT] + (size_t)l__ * MIXW * DM, MIXW, DM, (bf16_t*)(ws + WS_WOUT) + (size_t)l__ * DM * MIXW, scr__, lane, (worker_), (nworkers_), p.in[I_SUBLN] + l__ * 128, p.in[I_POOLS] + l__ * 512, p.in[I_GON] + l__ * 768, 1.f - li__); \
    transpose_matrix<2>(p.in[I_WUP] + (size_t)l__ * DM * DFF2, DM, DFF2, (bf16_t*)(ws + WS_WUP) + (size_t)l__ * DFF2 * DM, scr__, lane, (worker_), (nworkers_), nullptr, nullptr, nullptr, 0.f); \
    transpose_matrix<0>(p.in[I_WDN] + (size_t)l__ * DFF * DM, DFF, DM, (bf16_t*)(ws + WS_WDN) + (size_t)l__ * DM * DFF, scr__, lane, (worker_), (nworkers_), nullptr, nullptr, nullptr, 0.f); } while (0)
#define CONVERT_IN(l_, worker_, nworkers_) do { const int l__ = (l_); LAS float* scr__ = (LAS float*)(L + wave * 8704); \
    transpose_matrix<0>(p.in[I_WIN] + (size_t)l__ * DM * INC, DM, INC, (bf16_t*)(ws + WS_WIN) + (size_t)l__ * INC * DM, scr__, lane, (worker_), (nworkers_), nullptr, nullptr, nullptr, 0.f); } while (0)

__device__ __forceinline__ void norm_phase(float* X, bf16_t* H, const float* gain, const float* mod_l, int shift_off, int scale_off, int gw, int NGW, int lane, bool skip_ctx, const float* part, const float* pgate,
                                           const float* xlat  , const float* xctx  ) {
    for (int m = gw; m < MROWS; m += NGW) {
        const int b = m / TOK, t = m - b * TOK; const int r = t < CTX ? 4 : b;
        if (skip_ctx && t < CTX) continue;
        float* xr = X + (size_t)m * DM + lane * 4;
        const float* xs = xr;
        if (t < CTX) { if (xctx) xs = xctx + ((size_t)b * CTX + t) * DM + lane * 4; } else { if (xlat) xs = xlat + ((size_t)b * SEQ + (t - CTX)) * DM + lane * 4; }
        f32x4 v[8]; float ss = 0.f;
#pragma unroll
        for (int j = 0; j < 8; ++j) v[j] = *(const f32x4*)(xs + j * 256);
        if (part != nullptr && t < CTX) {
            const float* pr = part + (size_t)(b * 256 + t) * DM + lane * 4;
#pragma unroll
            for (int j = 0; j < 8; ++j) { f32x4 a = *(const f32x4*)(pr + j * 256);
#pragma unroll
                for (int ks = 1; ks < 8; ++ks) a += *(const f32x4*)(pr + (size_t)ks * 1024 * DM + j * 256);
                v[j] += *(const f32x4*)(pgate + lane * 4 + j * 256) * a; *(f32x4*)(xr + j * 256) = v[j]; }
        }
#pragma unroll
        for (int j = 0; j < 8; ++j) ss += (v[j].x * v[j].x + v[j].y * v[j].y) + (v[j].z * v[j].z + v[j].w * v[j].w);
        const float rstd = 1.0f / sqrtf(wave_sum(ss) * (1.f / DM) + EPS);
        const float* mr = mod_l + (size_t)r * NMOD6 + lane * 4;
        bf16_t* hr = H + (size_t)m * DM + lane * 4;
#pragma unroll
        for (int j = 0; j < 8; ++j) { const f32x4 g = *(const f32x4*)(gain + lane * 4 + j * 256), sc = *(const f32x4*)(mr + scale_off + j * 256), sh = *(const f32x4*)(mr + shift_off + j * 256);
            const f32x4 y = (v[j] * rstd * g) * (1.f + sc) + sh;
            u32x2 w; w.x = cvt_pk_bf16(y.x, y.y); w.y = cvt_pk_bf16(y.z, y.w); *(u32x2*)(hr + j * 256) = w; }
    }
}

__global__ void __launch_bounds__(512, 2) fwd_megakernel(Params p) {
    extern __shared__ __attribute__((aligned(16))) unsigned char lds[];
    cg::grid_group grid = cg::this_grid();
    const int G = gridDim.x, NGW = G * 8;
#define FRESH_IDS() int tid = threadIdx.x; asm volatile("" : "+v"(tid)); const int lane = tid & 63, wave = __builtin_amdgcn_readfirstlane(tid >> 6); int bid = blockIdx.x; asm volatile("" : "+s"(bid)); const int gw = bid * 8 + wave; (void)lane; (void)gw;
    unsigned char* ws = p.ws;
    float* MOD = (float*)(ws + WS_MOD);
    float* X = (float*)(ws + WS_X);
    bf16_t* H = (bf16_t*)(ws + WS_H);
    bf16_t* ACT = (bf16_t*)(ws + WS_ACT);
    bf16_t* U = (bf16_t*)(ws + WS_U);
    bf16_t* PROJ = (bf16_t*)(ws + WS_PROJ);
    float* AO = (float*)(ws + WS_AO);
    bf16_t* MRG = (bf16_t*)(ws + WS_MRG);
    float* PART = (float*)(ws + WS_PART);
    bf16_t* EDGE = (bf16_t*)(ws + WS_U + 190 * MiB);
    LAS unsigned char* L = (LAS unsigned char*)lds;
    volatile LAS unsigned* MISC = (volatile LAS unsigned*)(L + LDS_BYTES - 64);
    if (threadIdx.x < 16) MISC[threadIdx.x] = 0u;
    __syncthreads();
    if (blockIdx.x == 0 && threadIdx.x < 64) { unsigned* bw = (unsigned*)(ws + WS_CTL);
        for (int i = threadIdx.x; i < XCD_BAR_WORDS; i += 64) __hip_atomic_store(bw + i, 0u, __ATOMIC_RELAXED, __HIP_MEMORY_SCOPE_AGENT);
        asm volatile("s_waitcnt vmcnt(0)" ::: "memory"); }
    __syncthreads();
    grid.sync();
    XcdBarrier xbar = xcd_barrier_post((unsigned*)(ws + WS_CTL), MISC);
#define GRID_SYNC() xcd_barrier(xbar)

    {
        FRESH_IDS();
        LAS float* scv = (LAS float*)(L + 69632);
        LAS float* red = (LAS float*)(L + 69632 + 40960);
        for (int i = tid; i < 5 * DM; i += 512) { const int r = i >> 11, k = i & 2047; const float v = r < 4 ? p.in[I_C][r * DM + k] : p.in[I_CCTX][k]; scv[i] = silu_f(v); }
        __syncthreads();
        for (int task = bid; task < 192; task += G) {
            const int l = task / 96, j0 = (task % 96) * 128;
            const float* wp = p.in[I_WMOD] + ((size_t)l * DM + wave * 256) * NMOD6 + j0 + lane * 2;
            f32x2 a0 = {0.f, 0.f}, a1 = a0, a2 = a0, a3 = a0, a4 = a0;
#pragma unroll 16
            for (int k = 0; k < 256; ++k) { const f32x2 w = *(const f32x2*)(wp + (size_t)k * NMOD6); const int kk = wave * 256 + k;
                a0 += scv[kk] * w; a1 += scv[2048 + kk] * w; a2 += scv[4096 + kk] * w; a3 += scv[6144 + kk] * w; a4 += scv[8192 + kk] * w; }
            LAS float* rw = red + wave * 640 + lane * 2;
            rw[0] = a0.x; rw[1] = a0.y; rw[128] = a1.x; rw[129] = a1.y; rw[256] = a2.x; rw[257] = a2.y; rw[384] = a3.x; rw[385] = a3.y; rw[512] = a4.x; rw[513] = a4.y;
            __syncthreads();
            for (int i = tid; i < 640; i += 512) { const int r = i >> 7, jj = i & 127; float s = p.in[I_BMOD][l * NMOD6 + j0 + jj];
#pragma unroll
                for (int q = 0; q < 8; ++q) s += red[q * 640 + i];
                MOD[((size_t)l * 5 + r) * NMOD6 + j0 + jj] = s; }
            __syncthreads();
        }
        {
            const bool defer = (G == 256);
            CONVERT_IN(0, gw, NGW);
            { LAS float* scr = (LAS float*)(L + wave * 8704);
              for (int it = gw; it < 64; it += NGW) { const int l2 = it >> 5, r = it & 31, g = r >> 3;
                  transpose_item<0>(p.in[I_POOLW] + ((size_t)l2 * 4 + g) * 16384, 128, 128, (bf16_t*)(ws + WS_WPOOL) + ((size_t)l2 * 4 + g) * 16384, scr, r & 7, lane, nullptr, nullptr, nullptr, 0.f); } }
            CONVERT_IN(1, gw, NGW);
            if (!defer) { CONVERT_OUT_UP_DOWN(0, gw, NGW); CONVERT_OUT_UP_DOWN(1, gw, NGW); }
        }
    }
    GRID_SYNC();

    for (int l = 0; l < 2; ++l) {
        const bool last = (l == 1);
        const float lambda_init = l == 0 ? 0.2f : 0.35550906759f;
        const float* mod_l = MOD + (size_t)l * 5 * NMOD6;
        { FRESH_IDS(); norm_phase(X, H, p.in[I_NMIX] + l * DM, mod_l, 0, DM, gw, NGW, lane, false, (l == 1 && G == 256) ? PART : nullptr, MOD + 4 * NMOD6 + 5 * DM, l == 0 ? p.in[I_X] : nullptr, l == 0 ? p.in[I_CTX] : nullptr); }
        GRID_SYNC();
        { FRESH_IDS(); pg8::Gemm g{H, (const bf16_t*)(ws + WS_WIN) + (size_t)l * INC * DM, MROWS, INC, DM}; pg8::StaticOrder S; S.init(MROWS / 256, INC / 256, G, bid, 0, DM / 64);
          pg8::EpiBf16 E{PROJ, INC}; pg8::gemm_phase<pg8::EpiBf16, pg8::StaticOrder, true, true>(L, g, S, E, tid);
          if (l == 0 && G == 256 && bid >= 64) { __syncthreads(); CONVERT_OUT_UP_DOWN(0, (bid - 64) * 8 + wave, 192 * 8); } }
        GRID_SYNC();
        {
            FRESH_IDS();
            const float* qn = p.in[I_QN] + l * 128; const float* kn = p.in[I_KN] + l * 128;
            for (int m = gw; m < MROWS; m += NGW) {
                const int b = m / TOK, t = m - b * TOK; const bool lat = t >= CTX; const int s = t - CTX; const float prow = (float)(s >> 6), pcol = (float)(s & 63);
                bf16_t* pr = PROJ + (size_t)m * INC;
                if (lat) {
                    for (int pc = lane; pc < 96; pc += 64) { const int blk = pc >> 1, c = pc & 1; bf16_t* a = pr + blk * 32 + c * 8;
                        const float pos = (blk & 1) ? pcol : prow;
                        u32x4 va = *(const u32x4*)a, vb = *(const u32x4*)(a + 16); u32x4 oa, ob;
#pragma unroll
                        for (int e2 = 0; e2 < 4; ++e2) { float y1[2], y2[2];
#pragma unroll
                            for (int h = 0; h < 2; ++h) { const int i = c * 8 + e2 * 2 + h; const float x1 = h ? bfhi(va[e2]) : bflo(va[e2]), x2 = h ? bfhi(vb[e2]) : bflo(vb[e2]);
                                const float fr_ = __builtin_amdgcn_exp2f(-(float)i * (13.287712379549449f / 16.f)) * 0.15915494309189535f; float rev = pos * fr_; rev -= floorf(rev);
                                const float sn = __builtin_amdgcn_sinf(rev), cs = __builtin_amdgcn_cosf(rev);
                                y1[h] = x1 * cs - x2 * sn; y2[h] = x2 * cs + x1 * sn; }
                            oa[e2] = cvt_pk_bf16(y1[0], y1[1]); ob[e2] = cvt_pk_bf16(y2[0], y2[1]); }
                        *(u32x4*)a = oa; *(u32x4*)(a + 16) = ob; }
                }
                { const int head = lane >> 3, sub = lane & 7, blk64 = sub >> 2, c = sub & 3; bf16_t* a = pr + C_GQ + head * 128 + blk64 * 64 + c * 8;
                  const float* gp = (head < 6 ? qn : kn) + blk64 * 64 + c * 8; const float pos = blk64 ? pcol : prow;
                  u32x4 va = *(const u32x4*)a, vb = *(const u32x4*)(a + 32); float x1[8], x2[8]; float ss = 0.f;
#pragma unroll
                  for (int e2 = 0; e2 < 4; ++e2) { x1[2 * e2] = bflo(va[e2]); x1[2 * e2 + 1] = bfhi(va[e2]); x2[2 * e2] = bflo(vb[e2]); x2[2 * e2 + 1] = bfhi(vb[e2]); }
#pragma unroll
                  for (int e = 0; e < 8; ++e) ss += x1[e] * x1[e] + x2[e] * x2[e];
                  ss += __shfl_xor(ss, 1); ss += __shfl_xor(ss, 2); ss += __shfl_xor(ss, 4);
                  const float rstd = 1.0f / sqrtf(ss * (1.f / 128.f) + EPS);
                  u32x4 oa, ob;
#pragma unroll
                  for (int e2 = 0; e2 < 4; ++e2) { float y1[2], y2[2];
#pragma unroll
                      for (int h = 0; h < 2; ++h) { const int e = e2 * 2 + h, i = c * 8 + e; const float a1 = x1[e] * rstd * gp[e], a2 = x2[e] * rstd * gp[32 + e];
                          float sn = 0.f, cs = 1.f;
                          if (lat) { const float fr_ = __builtin_amdgcn_exp2f(-(float)i * (13.287712379549449f / 32.f)) * 0.15915494309189535f; float rev = pos * fr_; rev -= floorf(rev);
                              sn = __builtin_amdgcn_sinf(rev); cs = __builtin_amdgcn_cosf(rev); }
                          y1[h] = a1 * cs - a2 * sn; y2[h] = a2 * cs + a1 * sn; }
                      oa[e2] = cvt_pk_bf16(y1[0], y1[1]); ob[e2] = cvt_pk_bf16(y2[0], y2[1]); }
                  *(u32x4*)a = oa; *(u32x4*)(a + 32) = ob; }
            }
        }
        GRID_SYNC();
        {
            FRESH_IDS();
            float* AO1 = AO; float* AO2 = AO + (size_t)MROWS * 768; float* AOG = AO + (size_t)2 * MROWS * 768;
            for (int step = 0; step < 8; ++step) {
                int u = -1;
                if (G == 256) {
                    if (bid < 192) { if (step == 0) u = bid; else if (step == 1) u = 192 + bid; else if (step == 2 && !last && bid < 72) u = 576 + bid; }
                    else { if (step < 3) u = 192 + 192 + (bid - 192) * 3 + step; }
                } else { const int nu = last ? 576 : 648; const int uu = bid + step * G; if (uu < nu) u = uu; }
                if (u < 0) continue;
                int tid2 = tid; asm volatile("" : "+v"(tid2));
                int b, h, half = 0, qb = 0; const bool isctx = u >= 576; bool gqa;
                if (u < 192) { b = u / 48; const int rem = u % 48; h = rem >> 3; qb = rem & 7; gqa = true; }
                else if (u < 576) { const int v = u - 192; b = v / 96; const int rem = v % 96; h = rem >> 4; half = (rem >> 3) & 1; qb = rem & 7; gqa = false; }
                else if (u < 600) { const int v = u - 576; b = v / 6; h = v % 6; gqa = true; }
                else { const int v = u - 600; b = v / 12; const int rem = v % 12; h = rem >> 1; half = rem & 1; gqa = false; }
                const size_t r0 = (size_t)b * TOK, rq = isctx ? r0 : r0 + CTX + qb * 256; const int seq = isctx ? CTX : TOK;
                if (gqa) { const int kvh = h / 3;
                    att::attn_unit<128>(PROJ + rq * INC + C_GQ + h * 128, PROJ + r0 * INC + C_GK + kvh * 128, PROJ + r0 * INC + C_GV + kvh * 128, AOG + rq * 768 + h * 128, seq, (char*)lds, tid2);
                } else {
                    att::attn_unit<64>(PROJ + rq * INC + C_DAQ + h * 128 + half * 64, PROJ + r0 * INC + C_DAK + h * 128 + half * 64, PROJ + r0 * INC + C_DAV + h * 128, (half ? AO2 : AO1) + rq * 768 + h * 128, seq, (char*)lds, tid2);
                }
            }
        }
        {
            FRESH_IDS();
            const bool fill = (G != 256) || (bid < 192);
            const int pool_first = (G == 256) ? bid : bid, pool_stride = (G == 256) ? 192 : G;
            if (fill) {
                __syncthreads();
                const bf16_t* WP = (const bf16_t*)(ws + WS_WPOOL) + (size_t)l * 4 * 16384;
                LAS unsigned* tin = (LAS unsigned*)L;
                LAS unsigned char* tout = L + 20480;
                for (int it = pool_first; it < 576; it += pool_stride) {
                    const int tile = it >> 2, g = it & 3, m0 = tile * 64, b = m0 / TOK, t0 = m0 - b * TOK; const bool isctx = t0 < CTX;
                    if (last && isctx) continue;
                    const int slo = isctx ? 0 : CTX, shi = isctx ? CTX : TOK;
                    for (int idx = tid; idx < 1280; idx += 512) { const int row = idx >> 4, ch = idx & 15, t = t0 - 8 + row;
                        u32x4 v = {0u, 0u, 0u, 0u};
                        if (t >= slo && t < shi) v = *(const u32x4*)(PROJ + (size_t)(b * TOK + t) * INC + C_POOL + g * 128 + ch * 8);
                        *(LAS u32x4*)(tin + row * 64 + ch * 4) = v; }
                    bf16x8 wfr[4][4];
#pragma unroll
                    for (int q = 0; q < 4; ++q)
#pragma unroll
                        for (int ks = 0; ks < 4; ++ks) wfr[q][ks] = *(const bf16x8*)(WP + (size_t)g * 16384 + (size_t)(((wave & 1) * 4 + q) * 16 + (lane & 15)) * 128 + ks * 32 + (lane >> 4) * 8);
                    __syncthreads();
                    { const int w = 2 << g, hw = w >> 1, Tn = shi - slo, p0 = t0 - slo;
    #pragma unroll 1
                      for (int rr = 0; rr < 8; ++rr) { const int r = wave * 8 + rr, pp = p0 + r;
                          int lo = pp - hw; lo = lo < 0 ? 0 : lo; int hi2 = pp - hw + w; hi2 = hi2 > Tn ? Tn : hi2;
                          float s0 = 0.f, s1 = 0.f;
                          for (int j = lo; j < hi2; ++j) { const unsigned u = tin[(j - p0 + 8) * 64 + lane]; s0 += bflo(u); s1 += bfhi(u); }
                          const unsigned uc = tin[(r + 8) * 64 + lane]; const float inv = 1.0f / (float)(hi2 - lo);
                          *(LAS unsigned*)(tout + r * 272 + lane * 4) = cvt_pk_bf16(s0 * inv - bflo(uc), s1 * inv - bfhi(uc)); } }
                    __syncthreads();
                    { const int rb = wave >> 1, fr = lane & 15, fq = lane >> 4;
    #pragma unroll
                      for (int q = 0; q < 4; ++q) { const int nb = (wave & 1) * 4 + q; f32x4 acc = {0.f, 0.f, 0.f, 0.f};
    #pragma unroll
                          for (int ks = 0; ks < 4; ++ks) { const bf16x8 af = *(const LAS bf16x8*)(tout + (rb * 16 + fr) * 272 + (ks * 32 + fq * 8) * 2);
                              acc = __builtin_amdgcn_mfma_f32_16x16x32_bf16(wfr[q][ks], af, acc, 0, 0, 0); }
                          u32x2 o; o.x = cvt_pk_bf16(acc[0], acc[1]); o.y = cvt_pk_bf16(acc[2], acc[3]);
                          *(u32x2*)(MRG + (size_t)(m0 + rb * 16 + fr) * MIXW + 768 + g * 128 + nb * 16 + 4 * fq) = o; } }
                    __syncthreads();
                }


            }
        }
        GRID_SYNC();
        {
            FRESH_IDS();
            const float* AO1 = AO; const float* AO2 = AO + (size_t)MROWS * 768; const float* AOG = AO + (size_t)2 * MROWS * 768;
            const float s1 = wave_sum(p.in[I_LQ1][l * 64 + lane] * p.in[I_LK1][l * 64 + lane]), s2 = wave_sum(p.in[I_LQ2][l * 64 + lane] * p.in[I_LK2][l * 64 + lane]);
            const float lam = expf(s1) - expf(s2) + lambda_init;
            for (int m = gw; m < MROWS; m += NGW) {
                const int b = m / TOK, t = m - b * TOK; if (last && t < CTX) continue;
                bf16_t* mr = MRG + (size_t)m * MIXW + lane * 2;
                f32x2 da[6], db[6], v[6];
#pragma unroll
                for (int h = 0; h < 6; ++h) { da[h] = *(const f32x2*)(AO1 + (size_t)m * 768 + h * 128 + lane * 2); db[h] = *(const f32x2*)(AO2 + (size_t)m * 768 + h * 128 + lane * 2); v[h] = *(const f32x2*)(AOG + (size_t)m * 768 + h * 128 + lane * 2); }
                float ssd[6], ss = 0.f;
#pragma unroll
                for (int h = 0; h < 6; ++h) { da[h] = da[h] - lam * db[h]; ssd[h] = da[h].x * da[h].x + da[h].y * da[h].y; ss += v[h].x * v[h].x + v[h].y * v[h].y; }
#pragma unroll
                for (int o = 1; o < 64; o <<= 1) {
#pragma unroll
                    for (int h = 0; h < 6; ++h) ssd[h] += __shfl_xor(ssd[h], o);
                    ss += __shfl_xor(ss, o); }
#pragma unroll
                for (int h = 0; h < 6; ++h) { const float rs = 1.0f / sqrtf(ssd[h] * (1.f / 128.f) + EPS); *(unsigned*)(mr + h * 128) = cvt_pk_bf16(da[h].x * rs, da[h].y * rs); }
                const float rstd = 1.0f / sqrtf(ss * (1.f / 768.f) + EPS);
#pragma unroll
                for (int j = 0; j < 6; ++j) *(unsigned*)(mr + 1280 + j * 128) = cvt_pk_bf16(v[j].x * rstd, v[j].y * rstd);
            }
        }
        GRID_SYNC();
        { FRESH_IDS(); pg8::Gemm g{MRG, (const bf16_t*)(ws + WS_WOUT) + (size_t)l * DM * MIXW, MROWS, DM, MIXW}; pg8::StaticOrder S; S.init(last ? 32 : 36, DM / 256, G, bid, last ? 1 : 0, MIXW / 64, (!last && G == 256) ? 1 : 0);
          pg8::EpiResid E{X, mod_l + 2 * DM, PART, l == 0 ? p.in[I_X] : nullptr, l == 0 ? p.in[I_CTX] : nullptr}; pg8::gemm_phase<pg8::EpiResid, pg8::StaticOrder, true, true>(L, g, S, E, tid); }
        GRID_SYNC();
        { FRESH_IDS(); norm_phase(X, H, p.in[I_NFFN] + l * DM, mod_l, 3 * DM, 4 * DM, gw, NGW, lane, last, (l == 0 && G == 256) ? PART : nullptr, mod_l + 4 * NMOD6 + 2 * DM, nullptr, (l == 0 && G == 256) ? p.in[I_CTX] : nullptr); }
        GRID_SYNC();
        { FRESH_IDS(); pg8::Gemm g{H, (const bf16_t*)(ws + WS_WUP) + (size_t)l * DFF2 * DM, MROWS, DFF2, DM}; pg8::StaticOrder S; S.init(last ? 32 : 36, DFF2 / 256, G, bid, last ? 1 : 0, DM / 64);
          pg8::EpiConvAct E{ACT, EDGE, p.in[I_CONVW] + (size_t)l * 3 * DFF2, p.in[I_CONVB] + (size_t)l * DFF2, (LAS float*)(L + 131072)}; pg8::gemm_phase<pg8::EpiConvAct, pg8::StaticOrder, true, true>(L, g, S, E, tid);
          if (l == 0 && G == 256 && bid >= 48) { __syncthreads(); CONVERT_OUT_UP_DOWN(1, (bid - 48) * 8 + wave, 208 * 8); } }
        GRID_SYNC();
        {
            FRESH_IDS();
            pg8::StaticOrder S; S.init(last ? 32 : 36, DM / 256, G, bid, last ? 1 : 0, DFF / 64, (!last && G == 256) ? 1 : 0);
            const float* cw = p.in[I_CONVW] + (size_t)l * 3 * DFF2; const float* cb = p.in[I_CONVB] + (size_t)l * DFF2;
            pg8::Unit uu;
            for (int i = 0; S.next(i, uu); ++i) { const int pm = uu.pm, j = pm % 9 - 1; if (j < 0) continue;
                for (int idx = tid; idx < 2 * 704; idx += 512) { const int which = idx >= 704 ? 1 : 0, col = (idx - which * 704) * 8;
                    if (which == 0 ? (j == 0) : (j == 7)) continue;
                    const bf16_t* ru = which == 0 ? EDGE + (size_t)((pm - 1) * 4 + 3) * DFF2 : EDGE + (size_t)(pm * 4 + 2) * DFF2;
                    const bf16_t* rm = which == 0 ? EDGE + (size_t)(pm * 4 + 0) * DFF2 : EDGE + (size_t)(pm * 4 + 3) * DFF2;
                    const bf16_t* rd = which == 0 ? EDGE + (size_t)(pm * 4 + 1) * DFF2 : EDGE + (size_t)((pm + 1) * 4 + 0) * DFF2;
                    const u32x4 gu = *(const u32x4*)(ru + col), gm = *(const u32x4*)(rm + col), gd = *(const u32x4*)(rd + col);
                    const u32x4 vu = *(const u32x4*)(ru + DFF + col), vm = *(const u32x4*)(rm + DFF + col), vd = *(const u32x4*)(rd + DFF + col);
                    u32x4 o;
#pragma unroll
                    for (int e2 = 0; e2 < 4; ++e2) { float res[2];
                        const f32x2 wg0 = *(const f32x2*)(cw + col + e2 * 2), wg1 = *(const f32x2*)(cw + DFF2 + col + e2 * 2), wg2 = *(const f32x2*)(cw + 2 * DFF2 + col + e2 * 2), bg = *(const f32x2*)(cb + col + e2 * 2);
                        const f32x2 wv0 = *(const f32x2*)(cw + DFF + col + e2 * 2), wv1 = *(const f32x2*)(cw + DFF2 + DFF + col + e2 * 2), wv2 = *(const f32x2*)(cw + 2 * DFF2 + DFF + col + e2 * 2), bv = *(const f32x2*)(cb + DFF + col + e2 * 2);
#pragma unroll
                        for (int h = 0; h < 2; ++h) {
                            const float g0 = h ? bfhi(gu[e2]) : bflo(gu[e2]), g1 = h ? bfhi(gm[e2]) : bflo(gm[e2]), g2 = h ? bfhi(gd[e2]) : bflo(gd[e2]);
                            const float v0 = h ? bfhi(vu[e2]) : bflo(vu[e2]), v1 = h ? bfhi(vm[e2]) : bflo(vm[e2]), v2 = h ? bfhi(vd[e2]) : bflo(vd[e2]);
                            const float gg = wg0[h] * g0 + wg1[h] * g1 + wg2[h] * g2 + bg[h];
                            const float vv = wv0[h] * v0 + wv1[h] * v1 + wv2[h] * v2 + bv[h];
                            res[h] = silu_f(gg) * vv; }
                        o[e2] = cvt_pk_bf16(res[0], res[1]); }
                    *(u32x4*)(ACT + (size_t)(pm * 256 + (which ? 255 : 0)) * DFF + col) = o; } }
            asm volatile("s_waitcnt vmcnt(0)" ::: "memory"); __syncthreads();
        }
        { FRESH_IDS(); pg8::Gemm g{ACT, (const bf16_t*)(ws + WS_WDN) + (size_t)l * DM * DFF, MROWS, DM, DFF}; pg8::StaticOrder S; S.init(last ? 32 : 36, DM / 256, G, bid, last ? 1 : 0, DFF / 64, (!last && G == 256) ? 1 : 0);
          pg8::EpiResid E{X, mod_l + 5 * DM, PART, nullptr, nullptr}; pg8::gemm_phase<pg8::EpiResid, pg8::StaticOrder, true, true>(L, g, S, E, tid); }
        GRID_SYNC();
    }
    { FRESH_IDS();
    for (int i = gw; i < NB * SEQ; i += NGW) { const int b = i / SEQ, s = i - b * SEQ; const float* xr = X + ((size_t)b * TOK + CTX + s) * DM + lane * 4;
        f32x4 v[8]; float ss = 0.f;
#pragma unroll
        for (int j = 0; j < 8; ++j) { v[j] = *(const f32x4*)(xr + j * 256); ss += (v[j].x * v[j].x + v[j].y * v[j].y) + (v[j].z * v[j].z + v[j].w * v[j].w); }
        const float rstd = 1.0f / sqrtf(wave_sum(ss) * (1.f / DM) + EPS);
        float* orow = p.out + (size_t)i * DM + lane * 4;
#pragma unroll
        for (int j = 0; j < 8; ++j) { const f32x4 g = *(const f32x4*)(p.in[I_FN] + lane * 4 + j * 256); *(f32x4*)(orow + j * 256) = v[j] * rstd * g; } } }
}

extern "C" void kernel_launch(void* const* d_in, const int* in_sizes, int n_in, void* d_out, int out_size, void* d_ws, size_t ws_size, hipStream_t stream) {
    static int grid_blocks = 0;
    if (grid_blocks == 0) {
        if (n_in != 25 || ws_size < WS_END) { fprintf(stderr, "kernel_launch: n_in %d ws %zu (need %zu)\n", n_in, ws_size, (size_t)WS_END); grid_blocks = -1; return; }
        int dev = 0, cus = 0, per_cu = 0;
        hipGetDevice(&dev); hipDeviceGetAttribute(&cus, hipDeviceAttributeMultiprocessorCount, dev);
        if (hipFuncSetAttribute((const void*)fwd_megakernel, hipFuncAttributeMaxDynamicSharedMemorySize, LDS_BYTES) != hipSuccess) { fprintf(stderr, "kernel_launch: hipFuncSetAttribute failed\n"); grid_blocks = -1; return; }
        if (hipOccupancyMaxActiveBlocksPerMultiprocessor(&per_cu, (const void*)fwd_megakernel, 512, LDS_BYTES) != hipSuccess || per_cu < 1) { fprintf(stderr, "kernel_launch: occupancy query says %d\n", per_cu); per_cu = 1; }
        (void)hipGetLastError();
        grid_blocks = cus * 1;
        fprintf(stderr, "kernel_launch: cus %d per_cu %d grid %d\n", cus, per_cu, grid_blocks);
    }
    if (grid_blocks < 0) return;
    Params p{};
    for (int i = 0; i < 25; ++i) p.in[i] = (const float*)d_in[i];
    p.out = (float*)d_out; p.ws = (unsigned char*)d_ws; p.dbg = DBG_STOP;
    void* args[] = {&p};
    hipError_t e = hipLaunchCooperativeKernel((const void*)fwd_megakernel, dim3(grid_blocks), dim3(512), args, LDS_BYTES, stream);
    if (e != hipSuccess) fprintf(stderr, "cooperative launch failed: %s (grid %d)\n", hipGetErrorString(e), grid_blocks);
}
```

```cpp
#include <hip/hip_runtime.h>
#include <hip/hip_cooperative_groups.h>
#include <cstdio>
#include <cstdint>
namespace cg = cooperative_groups;

#define LAS __attribute__((address_space(3)))
typedef unsigned short bf16_t;
typedef short bf16x8 __attribute__((ext_vector_type(8)));
typedef short s16x4 __attribute__((ext_vector_type(4)));
typedef float f32x2 __attribute__((ext_vector_type(2)));
typedef float f32x4 __attribute__((ext_vector_type(4)));
typedef float f32x16 __attribute__((ext_vector_type(16)));
typedef unsigned u32x2 __attribute__((ext_vector_type(2)));
typedef unsigned u32x4 __attribute__((ext_vector_type(4)));

constexpr int NB = 4, SEQ = 2048, CTX = 256, TOK = SEQ + CTX  , MROWS = NB * TOK  ;
constexpr int DM = 2048, INC = 4096, MIXW = 2048, DFF = 5632, DFF2 = 11264, NMOD6 = 6 * DM  ;
constexpr int C_DAQ = 0, C_DAK = 768, C_DAV = 1536, C_POOL = 2304, C_GQ = 2816, C_GK = 3584, C_GV = 3840;
constexpr float EPS = 1e-6f;

constexpr size_t MiB = 1u << 20;
constexpr size_t WS_MOD = 0;
constexpr size_t WS_CTL = 512 * 1024, CTL_BYTES = 16384;
constexpr size_t WS_WPOOL = 1 * MiB;
constexpr size_t WS_WIN = 2 * MiB;
constexpr size_t WS_WOUT = WS_WIN + 32 * MiB;
constexpr size_t WS_WUP = WS_WOUT + 16 * MiB;
constexpr size_t WS_WDN = WS_WUP + 88 * MiB;
constexpr size_t WS_X = WS_WDN + 44 * MiB;
constexpr size_t WS_H = WS_X + 72 * MiB;
constexpr size_t WS_ACT = WS_H + 36 * MiB;
constexpr size_t WS_U = WS_ACT + 99 * MiB;
constexpr size_t WS_PROJ = WS_U;
constexpr size_t WS_AO = WS_PROJ + 72 * MiB;
constexpr size_t WS_MRG = WS_AO + 81 * MiB;
constexpr size_t WS_PART = WS_U + 198 * MiB;
constexpr size_t WS_END = WS_PART + 64 * MiB;
static_assert(WS_MRG + 36 * MiB <= WS_PART, "overlay");

typedef __bf16 bf16x2_t __attribute__((ext_vector_type(2)));
__device__ __forceinline__ unsigned cvt_pk_bf16(float lo, float hi) { f32x2 v = {lo, hi}; bf16x2_t b = __builtin_convertvector(v, bf16x2_t); return __builtin_bit_cast(unsigned, b); }
__device__ __forceinline__ float bflo(unsigned w) { return __uint_as_float(w << 16); }
__device__ __forceinline__ float bfhi(unsigned w) { return __uint_as_float(w & 0xffff0000u); }
__device__ __forceinline__ float wave_sum(float v) {
#pragma unroll
    for (int o = 1; o < 64; o <<= 1) v += __shfl_xor(v, o);
    return v;
}
__device__ __forceinline__ float silu_f(float v) { return v * __builtin_amdgcn_rcpf(1.f + __expf(-v)); }

namespace pg8 {
constexpr int BM = 256, BK = 64, HALF = 128, HTB = HALF * BK * 2, STAGE_BYTES = 8 * HTB, NXCD = 8, WGM = 8;
__host__ __device__ __forceinline__ int lds_byte(int r, int c) { const int st = (r >> 4) * 2 + (c >> 5), rr = r & 15, cc = c & 31, ob = rr * 64 + cc * 2; return st * 1024 + (ob ^ (((ob >> 9) & 1) << 5)); }
__host__ __device__ __forceinline__ void stage_rc(int b, int& R, int& C) { const int st = b / 1024, sb = b % 1024, swz = sb ^ (((sb >> 9) & 1) << 5); R = (st >> 1) * 16 + swz / 64; C = (st & 1) * 32 + (swz % 64) / 2; }
__host__ __device__ __forceinline__ int perm32(int rho) { const int n = rho >> 4, i = rho & 15; return 8 * (i >> 2) + 4 * n + (i & 3); }

struct Unit { int pm, pn, kt0, ktn, atomic, ks; };
struct Gemm { const bf16_t* A; const bf16_t* Bt; int M, N, K; };

struct StaticOrder {
    int nM, nN, nwg, G, c, skip;
    int nt, splitctx;
    __device__ __forceinline__ void init(int nM_, int nN_, int G_, int c_, int skip_, int nt_, int splitctx_ = 0) { nM = nM_; nN = nN_; nwg = nM * nN; G = G_; c = c_; skip = skip_; nt = nt_; splitctx = splitctx_; }
    __device__ __forceinline__ bool next(int i, Unit& u) const {
        u.kt0 = 0; u.ktn = nt; u.atomic = 0; u.ks = 0;
        if (splitctx) {
            if (i == 0) { const int rt = (c & 7) * 4 + (c >> 6); u.pm = (rt >> 3) * 9 + 1 + (rt & 7); u.pn = (c >> 3) & 7; return true; }
            if (i == 1) { const int cu = c >> 3, ks = c & 7; u.pm = (cu >> 3) * 9; u.pn = cu & 7; u.atomic = 1; u.ks = ks;
                if (nt == 32) { u.kt0 = 4 * ks; u.ktn = 4; } else { u.kt0 = 11 * ks + (ks & 1); u.ktn = (ks & 1) ? 10 : 12; }
                return true; }
            return false;
        }
        const long L = (long)i * G + c; if (L >= nwg) return false;
        int wgid = (int)L; { const int q = nwg / NXCD, r = nwg % NXCD, xcd = wgid % NXCD, off = wgid / NXCD; wgid = (xcd < r ? xcd * (q + 1) : r * (q + 1) + (xcd - r) * q) + off; }
        const int nig = WGM * nN, gid = wgid / nig, fm = gid * WGM, gsz = (nM - fm) < WGM ? (nM - fm) : WGM;
        int pm = fm + ((wgid % nig) % gsz); u.pn = (wgid % nig) / gsz;
        if (skip) pm = (pm >> 3) * 9 + 1 + (pm & 7);
        u.pm = pm; return true;
    }
    __device__ __forceinline__ void a_ready(const Unit&) const {}
    __device__ __forceinline__ void done(const Unit&) const {}
};

struct EpiBf16 {
    static constexpr bool PERM = true, AFTER_DRAIN = false;
    bf16_t* O; int ldc;
    __device__ __forceinline__ void operator()(const f32x4 (&acc)[2][2][4][2], const Unit& u, int wr, int wc, int fr, int fq) const {
        const int row0 = u.pm * BM + wr * 64 + fr; const int col0 = u.pn * BM + wc * 32 + 8 * fq;
#pragma unroll
        for (int ai = 0; ai < 2; ++ai)
#pragma unroll
            for (int m = 0; m < 4; ++m) { bf16_t* rowp = O + (size_t)(row0 + ai * HALF + m * 16) * ldc + col0;
#pragma unroll
                for (int bj = 0; bj < 2; ++bj) { const f32x4 v0 = acc[ai][bj][m][0], v1 = acc[ai][bj][m][1];
                    u32x4 w; w.x = cvt_pk_bf16(v0[0], v0[1]); w.y = cvt_pk_bf16(v0[2], v0[3]); w.z = cvt_pk_bf16(v1[0], v1[1]); w.w = cvt_pk_bf16(v1[2], v1[3]);
                    *(u32x4*)(rowp + bj * HALF) = w; } }
    }
};
struct EpiConvAct {
    static constexpr bool PERM = true, AFTER_DRAIN = false;
    bf16_t* ACT; bf16_t* EDGE; const float* cw; const float* cb; LAS float* xch;
    __device__ __forceinline__ void operator()(f32x4 (&acc)[2][2][4][2], const Unit& u, int wr, int wc, int fr_, int fq_) const {
        int fr = fr_, fq = fq_; asm volatile("" : "+v"(fr), "+v"(fq));
        const int jc = 32 * wc + 8 * fq, gcol = u.pn * 128 + jc;
        f32x4 Wc[2][4];
#define EPI_LOADW(buf, g) do { const int col_ = ((g) >> 1) * DFF + gcol + 4 * ((g) & 1); Wc[buf][0] = *(const f32x4*)(cw + col_); Wc[buf][1] = *(const f32x4*)(cw + DFF2 + col_); \
            Wc[buf][2] = *(const f32x4*)(cw + 2 * DFF2 + col_); Wc[buf][3] = *(const f32x4*)(cb + col_); } while (0)
        EPI_LOADW(0, 0);
        if (wr == 0 && fr < 2) { bf16_t* e = EDGE + (size_t)(u.pm * 4 + fr) * DFF2 + gcol;
#pragma unroll
            for (int bj = 0; bj < 2; ++bj) { const f32x4 a = acc[0][bj][0][0], b = acc[0][bj][0][1]; u32x4 w; w.x = cvt_pk_bf16(a[0], a[1]); w.y = cvt_pk_bf16(a[2], a[3]); w.z = cvt_pk_bf16(b[0], b[1]); w.w = cvt_pk_bf16(b[2], b[3]); *(u32x4*)(e + bj * DFF) = w; } }
        if (wr == 1 && fr >= 14) { bf16_t* e = EDGE + (size_t)(u.pm * 4 + 2 + (fr - 14)) * DFF2 + gcol;
#pragma unroll
            for (int bj = 0; bj < 2; ++bj) { const f32x4 a = acc[1][bj][3][0], b = acc[1][bj][3][1]; u32x4 w; w.x = cvt_pk_bf16(a[0], a[1]); w.y = cvt_pk_bf16(a[2], a[3]); w.z = cvt_pk_bf16(b[0], b[1]); w.w = cvt_pk_bf16(b[2], b[3]); *(u32x4*)(e + bj * DFF) = w; } }
#pragma unroll
        for (int ai = 0; ai < 2; ++ai) { const int q = ai * 2 + wr;
#pragma unroll
            for (int bj = 0; bj < 2; ++bj)
#pragma unroll
                for (int n = 0; n < 2; ++n) {
                    if (fr == 0)  *(LAS f32x4*)(xch + ((q * 2 + 0) * 2 + bj) * 128 + jc + 4 * n) = acc[ai][bj][0][n];
                    if (fr == 15) *(LAS f32x4*)(xch + ((q * 2 + 1) * 2 + bj) * 128 + jc + 4 * n) = acc[ai][bj][3][n]; } }
        asm volatile("s_waitcnt lgkmcnt(0)" ::: "memory"); __builtin_amdgcn_s_barrier(); asm volatile("" ::: "memory");
#pragma unroll
        for (int g = 0; g < 4; ++g) { const int bj = g >> 1, n = g & 1;
            if (g == 0) EPI_LOADW(1, 1); else if (g == 1) EPI_LOADW(0, 2); else if (g == 2) EPI_LOADW(1, 3);
            const f32x4 w0 = Wc[g & 1][0], w1 = Wc[g & 1][1], w2 = Wc[g & 1][2], bb = Wc[g & 1][3];
#pragma unroll
            for (int ai = 0; ai < 2; ++ai) { const int q = ai * 2 + wr;
                    const int qu = q > 0 ? q - 1 : 0, qd = q < 3 ? q + 1 : 3;
                    f32x4 bup = *(const LAS f32x4*)(xch + ((qu * 2 + 1) * 2 + bj) * 128 + jc + 4 * n), bdn = *(const LAS f32x4*)(xch + ((qd * 2 + 0) * 2 + bj) * 128 + jc + 4 * n);
                    const float mu = q > 0 ? 1.f : 0.f, md = q < 3 ? 1.f : 0.f; bup = bup * mu; bdn = bdn * md;
                    f32x4 R[4], O[4];
#pragma unroll
                    for (int m = 0; m < 4; ++m) R[m] = acc[ai][bj][m][n];
#pragma unroll
                    for (int m = 0; m < 4; ++m) { const f32x4 pv = m > 0 ? R[m - 1] : bup, nx = m < 3 ? R[m + 1] : bdn; f32x4 up, dn;
#pragma unroll
                        for (int e = 0; e < 4; ++e) {
                            up[e] = __builtin_bit_cast(float, __builtin_amdgcn_mov_dpp(__builtin_bit_cast(int, fr == 15 ? pv[e] : R[m][e]), 0x121  , 0xf, 0xf, false));
                            dn[e] = __builtin_bit_cast(float, __builtin_amdgcn_mov_dpp(__builtin_bit_cast(int, fr == 0 ? nx[e] : R[m][e]), 0x12f  , 0xf, 0xf, false)); }
                        O[m] = __builtin_elementwise_fma(w0, up, __builtin_elementwise_fma(w1, R[m], __builtin_elementwise_fma(w2, dn, bb))); }
#pragma unroll
                    for (int m = 0; m < 4; ++m) acc[ai][bj][m][n] = O[m];
            }
            asm volatile("" ::: "memory"); }
#undef EPI_LOADW
#pragma unroll
        for (int ai = 0; ai < 2; ++ai)
#pragma unroll
            for (int m = 0; m < 4; ++m) { const f32x4 g0 = acc[ai][0][m][0], g1 = acc[ai][0][m][1], v0 = acc[ai][1][m][0], v1 = acc[ai][1][m][1];
                u32x4 w; w.x = cvt_pk_bf16(silu_f(g0[0]) * v0[0], silu_f(g0[1]) * v0[1]); w.y = cvt_pk_bf16(silu_f(g0[2]) * v0[2], silu_f(g0[3]) * v0[3]);
                w.z = cvt_pk_bf16(silu_f(g1[0]) * v1[0], silu_f(g1[1]) * v1[1]); w.w = cvt_pk_bf16(silu_f(g1[2]) * v1[2], silu_f(g1[3]) * v1[3]);
                *(u32x4*)(ACT + (size_t)(u.pm * BM + ai * HALF + wr * 64 + m * 16 + fr) * DFF + gcol) = w; }
    }
};
struct EpiResid {
    static constexpr bool PERM = false, AFTER_DRAIN = false;
    float* X; const float* gate; float* part; const float* xin_lat; const float* xin_ctx;
    __device__ __forceinline__ void operator()(const f32x4 (&acc)[2][2][4][2], const Unit& u, int wr, int wc, int fr_, int fq_) const {
        int fr = fr_, fq = fq_; asm volatile("" : "+v"(fr), "+v"(fq));
        const int bb = u.pm / 9, r = (u.pm - bb * 9 == 0) ? 4 : bb;
        const int col0 = u.pn * BM + wc * 32 + 4 * fq;
        const float* g = gate + (size_t)r * NMOD6 + col0;
        f32x4 gv[2][2];
#pragma unroll
        for (int bj = 0; bj < 2; ++bj)
#pragma unroll
            for (int n = 0; n < 2; ++n) gv[bj][n] = *(const f32x4*)(g + bj * HALF + n * 16);
        if (u.atomic) {
#pragma unroll
            for (int ai = 0; ai < 2; ++ai)
#pragma unroll
                for (int m = 0; m < 4; ++m)
#pragma unroll
                    for (int bj = 0; bj < 2; ++bj)
#pragma unroll
                        for (int n = 0; n < 2; ++n) *(f32x4*)(part + ((size_t)(u.ks * 1024 + bb * 256 + ai * HALF + wr * 64 + m * 16 + fr)) * DM + col0 + bj * HALF + n * 16) = acc[ai][bj][m][n];
            return;
        }
        const int jt = u.pm - bb * 9;
#pragma unroll
        for (int ai = 0; ai < 2; ++ai) {
            f32x4 xv[4][2][2];
#pragma unroll
            for (int m = 0; m < 4; ++m) { const int rr = ai * HALF + wr * 64 + m * 16 + fr;
                const float* xs = X + (size_t)(u.pm * BM + rr) * DM + col0;
                if (jt == 0) { if (xin_ctx) xs = xin_ctx + ((size_t)bb * CTX + rr) * DM + col0; } else { if (xin_lat) xs = xin_lat + ((size_t)bb * SEQ + (jt - 1) * 256 + rr) * DM + col0; }
#pragma unroll
                for (int bj = 0; bj < 2; ++bj)
#pragma unroll
                    for (int n = 0; n < 2; ++n) xv[m][bj][n] = *(const f32x4*)(xs + bj * HALF + n * 16); }
            asm volatile("" ::: "memory");
#pragma unroll
            for (int m = 0; m < 4; ++m) { float* xp = X + (size_t)(u.pm * BM + ai * HALF + wr * 64 + m * 16 + fr) * DM + col0;
#pragma unroll
                for (int bj = 0; bj < 2; ++bj)
#pragma unroll
                    for (int n = 0; n < 2; ++n) *(f32x4*)(xp + bj * HALF + n * 16) = xv[m][bj][n] + gv[bj][n] * acc[ai][bj][m][n]; }
            asm volatile("" ::: "memory");
        }
    }
};

template <class Epi, class Sched, bool ALIGN_EPI = false, bool SP2 = false>
__device__ __forceinline__ void gemm_phase(LAS unsigned char* lds, const Gemm g, const Sched& S, const Epi& E, const int tid) {
    const int wid = __builtin_amdgcn_readfirstlane(tid >> 6), lane = tid & 63, wr = wid >> 2, wc = wid & 3, fr = lane & 15, fq = lane >> 4;
    const int K = g.K;
    unsigned voffA[2], voffB[2];
#pragma unroll
    for (int i = 0; i < 2; ++i) { int R, C; stage_rc(tid * 16 + i * 8192, R, C); const int Rb = Epi::PERM ? ((R & ~31) + perm32(R & 31)) : R;
        voffA[i] = (unsigned)(R * K + C) * 2u; voffB[i] = (unsigned)(Rb * K + C) * 2u; }
    const size_t kstep = (size_t)(BK * 2);
    const size_t hstep = (size_t)HALF * K * 2;
    const size_t tstep = 2 * hstep;
    const unsigned ldsw = (unsigned)wid * 1024u;
    const int aoff = lds_byte(wr * 64 + fr, fq * 8), boff = lds_byte(wc * 32 + fr, fq * 8);
#define PG8_SA(b, h) (((b) * 2 + (h)) * HTB)
#define PG8_SB(b, h) ((4 + (b) * 2 + (h)) * HTB)
#define PG8_STAGE(bufoff, gbase, voff) do { _Pragma("unroll") for (int _i = 0; _i < 2; ++_i) \
        __builtin_amdgcn_global_load_lds((const unsigned*)((const char*)(gbase) + (voff)[_i]), (LAS unsigned*)(lds + (bufoff) + ldsw + _i * 8192), 16, 0, 0); } while (0)
#define PG8_LDA(dst, b, h) do { _Pragma("unroll") for (int m = 0; m < 4; ++m) _Pragma("unroll") for (int k = 0; k < 2; ++k) dst[m][k] = *(const LAS bf16x8*)(lds + PG8_SA(b, h) + aoff + m * 2048 + k * 1024); } while (0)
#define PG8_LDB(dst, b, h) do { _Pragma("unroll") for (int n = 0; n < 2; ++n) _Pragma("unroll") for (int k = 0; k < 2; ++k) dst[n][k] = *(const LAS bf16x8*)(lds + PG8_SB(b, h) + boff + n * 2048 + k * 1024); } while (0)
#define PG8_MMA(ai, bj, At, Bt) do { __builtin_amdgcn_s_setprio(1); _Pragma("unroll") for (int m = 0; m < 4; ++m) _Pragma("unroll") for (int n = 0; n < 2; ++n) _Pragma("unroll") for (int k = 0; k < 2; ++k) \
        acc[ai][bj][m][n] = __builtin_amdgcn_mfma_f32_16x16x32_bf16(Bt[n][k], At[m][k], acc[ai][bj][m][n], 0, 0, 0); __builtin_amdgcn_s_setprio(0); } while (0)
#define PG8_WAIT_V(n) asm volatile("s_waitcnt vmcnt(" #n ")" ::: "memory")
#define PG8_WAIT_L(n) asm volatile("s_waitcnt lgkmcnt(" #n ")" ::: "memory")
#define PG8_BAR __builtin_amdgcn_s_barrier()
#define PG8_SCHED __builtin_amdgcn_sched_barrier(0)
    Unit cur, nxt; int ui = 0;
    if (!S.next(0, cur)) return;
    f32x4 acc[2][2][4][2];
#pragma unroll
    for (int a = 0; a < 2; ++a)
#pragma unroll
        for (int b = 0; b < 2; ++b)
#pragma unroll
            for (int m = 0; m < 4; ++m)
#pragma unroll
                for (int n = 0; n < 2; ++n) acc[a][b][m][n] = (f32x4){0.f, 0.f, 0.f, 0.f};
    bf16x8 At[4][2], B0[2][2], B1[2][2];
    const char* cA = (const char*)g.A + (size_t)cur.pm * tstep + (size_t)cur.kt0 * kstep; const char* cB = (const char*)g.Bt + (size_t)cur.pn * tstep + (size_t)cur.kt0 * kstep;
    S.a_ready(cur);
    if constexpr (SP2) {
        PG8_STAGE(PG8_SB(0, 0), cB, voffB); PG8_STAGE(PG8_SB(0, 1), cB + hstep, voffB); PG8_STAGE(PG8_SA(0, 0), cA, voffA); PG8_STAGE(PG8_SA(0, 1), cA + hstep, voffA);
        if (wr == 1) PG8_BAR;
        PG8_WAIT_V(2); PG8_BAR;
        PG8_STAGE(PG8_SB(1, 0), cB + kstep, voffB); PG8_STAGE(PG8_SA(1, 0), cA + kstep, voffA); PG8_STAGE(PG8_SB(1, 1), cB + hstep + kstep, voffB);
        PG8_WAIT_V(6); PG8_BAR;
    } else {
        PG8_STAGE(PG8_SB(0, 0), cB, voffB); PG8_STAGE(PG8_SA(0, 0), cA, voffA); PG8_STAGE(PG8_SB(0, 1), cB + hstep, voffB); PG8_STAGE(PG8_SA(0, 1), cA + hstep, voffA);
        if (wr == 1) PG8_BAR;
        PG8_WAIT_V(4); PG8_BAR;
        PG8_STAGE(PG8_SB(1, 0), cB + kstep, voffB); PG8_STAGE(PG8_SA(1, 0), cA + kstep, voffA); PG8_STAGE(PG8_SB(1, 1), cB + hstep + kstep, voffB);
        PG8_WAIT_V(6); PG8_BAR;
    }
    for (;;) {
        const bool has_next = S.next(ui + 1, nxt);
        const char* nA = has_next ? (const char*)g.A + (size_t)nxt.pm * tstep + (size_t)nxt.kt0 * kstep : cA; const char* nB = has_next ? (const char*)g.Bt + (size_t)nxt.pn * tstep + (size_t)nxt.kt0 * kstep : cB;
        const int nt = cur.ktn;
        for (int t = 0; t < nt; t += 2) {
            const bool last = (t == nt - 2);
            const char* a1 = cA + (size_t)(t + 1) * kstep;
            const char* a2 = last ? nA : cA + (size_t)(t + 2) * kstep; const char* b2 = last ? nB : cB + (size_t)(t + 2) * kstep;
            const char* a3 = a2 + kstep; const char* b3 = b2 + kstep;
            if (last && has_next) S.a_ready(nxt);
            if constexpr (SP2) {
            PG8_LDB(B0, 0, 0); PG8_LDB(B1, 0, 1); PG8_SCHED; PG8_LDA(At, 0, 0); PG8_STAGE(PG8_SA(1, 1), a1 + hstep, voffA);
            PG8_WAIT_V(8); PG8_WAIT_L(0); PG8_BAR; PG8_MMA(0, 0, At, B0); PG8_MMA(0, 1, At, B1); PG8_BAR; PG8_SCHED;
            PG8_LDA(At, 0, 1); PG8_STAGE(PG8_SB(0, 0), b2, voffB); PG8_STAGE(PG8_SB(0, 1), b2 + hstep, voffB); PG8_STAGE(PG8_SA(0, 0), a2, voffA);
            PG8_WAIT_V(8); PG8_WAIT_L(0); PG8_BAR; PG8_MMA(1, 0, At, B0); PG8_MMA(1, 1, At, B1); PG8_BAR; PG8_SCHED;
            PG8_LDB(B0, 1, 0); PG8_LDB(B1, 1, 1); PG8_SCHED; PG8_LDA(At, 1, 0); PG8_STAGE(PG8_SA(0, 1), a2 + hstep, voffA);
            PG8_WAIT_V(8); PG8_WAIT_L(0); PG8_BAR; PG8_MMA(0, 0, At, B0); PG8_MMA(0, 1, At, B1); PG8_BAR; PG8_SCHED;
            PG8_LDA(At, 1, 1); PG8_STAGE(PG8_SB(1, 0), b3, voffB); PG8_STAGE(PG8_SB(1, 1), b3 + hstep, voffB); PG8_STAGE(PG8_SA(1, 0), a3, voffA);
            PG8_WAIT_V(8); PG8_WAIT_L(0); PG8_BAR; PG8_MMA(1, 0, At, B0); PG8_MMA(1, 1, At, B1); PG8_BAR; PG8_SCHED;
            } else {
            PG8_LDB(B0, 0, 0); PG8_SCHED; PG8_LDA(At, 0, 0); PG8_STAGE(PG8_SA(1, 1), a1 + hstep, voffA);
            PG8_WAIT_L(8); PG8_BAR; PG8_WAIT_L(0); PG8_MMA(0, 0, At, B0); PG8_BAR; PG8_SCHED;
            PG8_LDB(B1, 0, 1); PG8_STAGE(PG8_SB(0, 0), b2, voffB);
            PG8_BAR; PG8_WAIT_L(0); PG8_MMA(0, 1, At, B1); PG8_BAR;
            PG8_LDA(At, 0, 1); PG8_STAGE(PG8_SA(0, 0), a2, voffA);
            PG8_BAR; PG8_WAIT_L(0); PG8_MMA(1, 0, At, B0); PG8_BAR; PG8_SCHED;
            PG8_STAGE(PG8_SB(0, 1), b2 + hstep, voffB);
            PG8_WAIT_V(6); PG8_BAR; PG8_MMA(1, 1, At, B1); PG8_BAR;
            PG8_LDB(B0, 1, 0); PG8_SCHED; PG8_LDA(At, 1, 0); PG8_STAGE(PG8_SA(0, 1), a2 + hstep, voffA);
            PG8_WAIT_L(8); PG8_BAR; PG8_WAIT_L(0); PG8_MMA(0, 0, At, B0); PG8_BAR; PG8_SCHED;
            PG8_LDB(B1, 1, 1); PG8_STAGE(PG8_SB(1, 0), b3, voffB);
            PG8_BAR; PG8_WAIT_L(0); PG8_MMA(0, 1, At, B1); PG8_BAR;
            PG8_LDA(At, 1, 1); PG8_STAGE(PG8_SA(1, 0), a3, voffA);
            PG8_BAR; PG8_WAIT_L(0); PG8_MMA(1, 0, At, B0); PG8_BAR; PG8_SCHED;
            PG8_STAGE(PG8_SB(1, 1), b3 + hstep, voffB);
            PG8_WAIT_V(6); PG8_BAR; PG8_MMA(1, 1, At, B1); PG8_BAR;
            }
        }
        if constexpr (ALIGN_EPI) { if (wr == 0) PG8_BAR; }
        if constexpr (!Epi::AFTER_DRAIN) { E(acc, cur, wr, wc, fr, fq); S.done(cur); }
        if (!has_next) break;
#pragma unroll
        for (int a = 0; a < 2; ++a)
#pragma unroll
            for (int b = 0; b < 2; ++b)
#pragma unroll
                for (int m = 0; m < 4; ++m)
#pragma unroll
                    for (int n = 0; n < 2; ++n) acc[a][b][m][n] = (f32x4){0.f, 0.f, 0.f, 0.f};
        cur = nxt; cA = nA; cB = nB; ++ui;
        if constexpr (ALIGN_EPI) { if (wr == 1) PG8_BAR; }
    }
    PG8_WAIT_V(0);
    if constexpr (!ALIGN_EPI) { if (wr == 0) PG8_BAR; }
    PG8_BAR;
#undef PG8_SA
#undef PG8_SB
#undef PG8_STAGE
#undef PG8_LDA
#undef PG8_LDB
#undef PG8_MMA
#undef PG8_WAIT_V
#undef PG8_WAIT_L
#undef PG8_BAR
#undef PG8_SCHED
}
}

namespace att {
constexpr int NW = 8, QBLK = 32, KVBLK = 64, LDP = INC  , LDO = 768;
constexpr float THR = 8.f;
constexpr int SHM_V = KVBLK * 128 * 2;
#define SBAR() __builtin_amdgcn_sched_barrier(0)
__device__ __forceinline__ int crow(int r, int hi) { return (r & 3) + 8 * (r >> 2) + 4 * hi; }
template <int DK> __device__ __forceinline__ int kswz(int row, int colB) { return row * (DK * 2) + (colB ^ ((row & 7) << 4)); }

template <int DK> __device__ __forceinline__ void partialSM(f32x16& p0, f32x16& p1, float& m_reg, float& mn, float& alpha) {
  constexpr float SCALE = (DK == 128) ? 0.088388347648318440f : 0.125f;
  constexpr float C = SCALE * 1.4426950408889634f;
  float pmax = p0[0];
#pragma unroll
  for (int r = 1; r < 16; ++r) pmax = fmaxf(pmax, p0[r]);
#pragma unroll
  for (int r = 0; r < 16; ++r) pmax = fmaxf(pmax, p1[r]);
  { auto rr = __builtin_amdgcn_permlane32_swap(__float_as_uint(pmax), __float_as_uint(pmax), false, false);
    pmax = fmaxf(__uint_as_float(rr[0]), __uint_as_float(rr[1])); }
  if (__builtin_expect(__all(pmax - m_reg <= THR / SCALE), 1)) { mn = m_reg; alpha = 1.f; }
  else { mn = fmaxf(m_reg, pmax); alpha = __builtin_amdgcn_exp2f((m_reg - mn) * C); m_reg = mn; }
  float mnC = -mn * C;
#pragma unroll
  for (int r = 0; r < 16; ++r) p0[r] = fmaf(p0[r], C, mnC);
#pragma unroll
  for (int r = 0; r < 16; ++r) p1[r] = fmaf(p1[r], C, mnC);
#pragma unroll
  for (int r = 0; r < 16; ++r) p0[r] = __builtin_amdgcn_exp2f(p0[r]);
}
__device__ __forceinline__ void finishSM(f32x16& p0, f32x16& p1, float alpha, float& l_reg, bf16x8& pa0, bf16x8& pa1, bf16x8& pa2, bf16x8& pa3) {
#pragma unroll
  for (int r = 0; r < 16; ++r) p1[r] = __builtin_amdgcn_exp2f(p1[r]);
  float ps = 0;
#pragma unroll
  for (int r = 0; r < 16; ++r) ps += p0[r];
#pragma unroll
  for (int r = 0; r < 16; ++r) ps += p1[r];
  { auto rr = __builtin_amdgcn_permlane32_swap(__float_as_uint(ps), __float_as_uint(ps), false, false);
    ps = __uint_as_float(rr[0]) + __uint_as_float(rr[1]); }
  l_reg = l_reg * alpha + ps;
#define PK4(P, BASE, OUT) do { unsigned a0 = cvt_pk_bf16(P[BASE + 0], P[BASE + 1]), a1 = cvt_pk_bf16(P[BASE + 2], P[BASE + 3]);   \
    unsigned b0 = cvt_pk_bf16(P[BASE + 4], P[BASE + 5]), b1 = cvt_pk_bf16(P[BASE + 6], P[BASE + 7]);                              \
    auto r0 = __builtin_amdgcn_permlane32_swap(a0, b0, false, false); auto r1 = __builtin_amdgcn_permlane32_swap(a1, b1, false, false); \
    u32x4 w = {r0[0], r1[0], r0[1], r1[1]}; OUT = *reinterpret_cast<bf16x8*>(&w); } while (0)
  PK4(p0, 0, pa0); PK4(p0, 8, pa1); PK4(p1, 0, pa2); PK4(p1, 8, pa3);
#undef PK4
}
template <int DK> __device__ __forceinline__ void qkt(f32x16& p0, f32x16& p1, const char* Ks, const bf16x8* qr, int r32, int hi) {
  p0 = f32x16{}; p1 = f32x16{};
#pragma unroll
  for (int d0 = 0; d0 < DK / 16; ++d0) { int cb = (d0 * 16 + hi * 8) * 2;
    bf16x8 b0 = *reinterpret_cast<const bf16x8*>(Ks + kswz<DK>(r32, cb));
    bf16x8 b1 = *reinterpret_cast<const bf16x8*>(Ks + kswz<DK>(32 + r32, cb));
    p0 = __builtin_amdgcn_mfma_f32_32x32x16_bf16(b0, qr[d0], p0, 0, 0, 0);
    p1 = __builtin_amdgcn_mfma_f32_32x32x16_bf16(b1, qr[d0], p1, 0, 0, 0); }
}
__device__ __forceinline__ int v_st(int k, int c) { const int kk = (k & ~0xC) | ((k & 4) << 1) | ((k & 8) >> 1); return ((kk >> 3) * 4 + (c >> 5)) * 512 + ((kk & 7) * 32 + (c & 31)) * 2; }
__device__ __forceinline__ int v_rd_base(int lane) { return ((lane & 3) << 3) | (((lane >> 2) & 3) << 6) | (((lane >> 4) & 1) << 5) | (((lane >> 5) & 1) << 8); }
constexpr int v_rd_off(int d0, int ks, int half) { return d0 * 512 + ks * 4096 + half * 2048; }
template <int OFF> __device__ __forceinline__ s16x4 tr_read(int vb) {
  s16x4 r; asm volatile("ds_read_b64_tr_b16 %0, %1 offset:%2" : "=&v"(r) : "v"(vb), "i"(OFF) : "memory"); return r;
}
template <int D0> __device__ __forceinline__ void pv_one(f32x16& od, int vb, bf16x8 pa0, bf16x8 pa1, bf16x8 pa2, bf16x8 pa3) {
  const s16x4 l0 = tr_read<v_rd_off(D0, 0, 0)>(vb), h0 = tr_read<v_rd_off(D0, 0, 1)>(vb), l1 = tr_read<v_rd_off(D0, 1, 0)>(vb), h1 = tr_read<v_rd_off(D0, 1, 1)>(vb);
  const s16x4 l2 = tr_read<v_rd_off(D0, 2, 0)>(vb), h2 = tr_read<v_rd_off(D0, 2, 1)>(vb), l3 = tr_read<v_rd_off(D0, 3, 0)>(vb), h3 = tr_read<v_rd_off(D0, 3, 1)>(vb);
  asm volatile("s_waitcnt lgkmcnt(0)" ::: "memory"); SBAR();
#define PK(L, H) (bf16x8){L[0], L[1], L[2], L[3], H[0], H[1], H[2], H[3]}
  od = __builtin_amdgcn_mfma_f32_32x32x16_bf16(pa0, PK(l0, h0), od, 0, 0, 0);
  od = __builtin_amdgcn_mfma_f32_32x32x16_bf16(pa1, PK(l1, h1), od, 0, 0, 0);
  od = __builtin_amdgcn_mfma_f32_32x32x16_bf16(pa2, PK(l2, h2), od, 0, 0, 0);
  od = __builtin_amdgcn_mfma_f32_32x32x16_bf16(pa3, PK(l3, h3), od, 0, 0, 0);
#undef PK
}
__device__ __forceinline__ void pv_d0(f32x16* o, int vb, bf16x8 pa0, bf16x8 pa1, bf16x8 pa2, bf16x8 pa3) {
  pv_one<0>(o[0], vb, pa0, pa1, pa2, pa3); pv_one<1>(o[1], vb, pa0, pa1, pa2, pa3); pv_one<2>(o[2], vb, pa0, pa1, pa2, pa3); pv_one<3>(o[3], vb, pa0, pa1, pa2, pa3);
}

template <int DK>
__device__ __forceinline__ void attn_unit(const bf16_t* __restrict__ Qb, const bf16_t* __restrict__ Kh, const bf16_t* __restrict__ Vh,
                                          float* __restrict__ Ob, int seq, char* lds, const int tid) {
  constexpr int SHM_K = KVBLK * DK * 2;
  const int wid = tid >> 6, lane = tid & 63, r32 = lane & 31, hi = lane >> 5;
  char* V_lds = lds; char* K_lds = lds + 2 * SHM_V;
  float* ws = (float*)(lds + 2 * SHM_V + 2 * SHM_K) + wid * 64; float* li_l = ws; float* al_l = ws + 32;
  float m_reg = -1e30f, l_reg = 0; f32x16 o[4] = {}; bf16x8 qr[DK / 16];
  const bf16_t* Qw = Qb + (long)(wid * QBLK + r32) * LDP + hi * 8;
#pragma unroll
  for (int d0 = 0; d0 < DK / 16; ++d0) qr[d0] = *reinterpret_cast<const bf16x8*>(Qw + d0 * 16);
  const int sr = tid >> 4, sc = (tid & 15) * 8, vst0 = v_st(sr, sc), vst1 = v_st(32 + sr, sc);
  const int ksr = (DK == 128) ? sr : (tid >> 3), ksc = (DK == 128) ? sc : ((tid & 7) * 8);
  const int vb0 = (int)(uintptr_t)V_lds + v_rd_base(lane);
  struct { bf16x8 vs0, vs1, ks0, ks1; } sr_[2];
#define SLOAD(i, k0) do { sr_[i].vs0 = *reinterpret_cast<const bf16x8*>(&Vh[(long)((k0) + sr) * LDP + sc]); sr_[i].vs1 = *reinterpret_cast<const bf16x8*>(&Vh[(long)((k0) + 32 + sr) * LDP + sc]); \
    sr_[i].ks0 = *reinterpret_cast<const bf16x8*>(&Kh[(long)((k0) + ksr) * LDP + ksc]); if constexpr (DK == 128) sr_[i].ks1 = *reinterpret_cast<const bf16x8*>(&Kh[(long)((k0) + 32 + ksr) * LDP + ksc]); } while (0)
#define SWRITE(b, i) do { *(bf16x8*)(V_lds + (b) * SHM_V + vst0) = sr_[i].vs0;          \
    *(bf16x8*)(V_lds + (b) * SHM_V + vst1) = sr_[i].vs1; int kc = ksc * 2;               \
    *(bf16x8*)(K_lds + (b) * SHM_K + kswz<DK>(ksr, kc)) = sr_[i].ks0;                       \
    if constexpr (DK == 128) *(bf16x8*)(K_lds + (b) * SHM_K + kswz<DK>(32 + ksr, kc)) = sr_[i].ks1; } while (0)
#define SWAIT() do { if constexpr (DK == 128) asm volatile("s_waitcnt vmcnt(4)" ::: "memory"); else asm volatile("s_waitcnt vmcnt(3)" ::: "memory"); } while (0)
#define RESC(a) do { if (__any((a) < 1.f)) { if (hi == 0) al_l[r32] = (a); asm volatile("s_waitcnt lgkmcnt(0)" ::: "memory"); \
    _Pragma("unroll") for (int d = 0; d < 4; ++d) _Pragma("unroll") for (int r = 0; r < 16; ++r) o[d][r] *= al_l[crow(r, hi)]; } } while (0)
  f32x16 pA0, pA1, pB0, pB1; float mnA, mnB, alA, alB; bf16x8 pa0, pa1, pa2, pa3; const int NT = seq / KVBLK;
  constexpr int SE = 0, SO = 1;
  SLOAD(SE, 0); asm volatile("s_waitcnt vmcnt(0)" ::: "memory"); SWRITE(0, SE); __syncthreads();
  qkt<DK>(pA0, pA1, K_lds, qr, r32, hi); partialSM<DK>(pA0, pA1, m_reg, mnA, alA);
  SLOAD(SO, KVBLK); if (2 < NT) SLOAD(SE, 2 * KVBLK);
  SWAIT(); SWRITE(1, SO); __syncthreads();
  for (int j = 1; j + 1 < NT; j += 2) {
    SBAR(); qkt<DK>(pB0, pB1, K_lds + SHM_K, qr, r32, hi);
    finishSM(pA0, pA1, alA, l_reg, pa0, pa1, pa2, pa3); SBAR();
    SLOAD(SO, (j + 2) * KVBLK); SBAR();
    pv_d0(o, vb0, pa0, pa1, pa2, pa3); partialSM<DK>(pB0, pB1, m_reg, mnB, alB);
    __syncthreads(); SWAIT(); SWRITE(0, SE);
    RESC(alB); __syncthreads();
    SBAR(); qkt<DK>(pA0, pA1, K_lds, qr, r32, hi);
    finishSM(pB0, pB1, alB, l_reg, pa0, pa1, pa2, pa3); SBAR();
    if (j + 3 < NT) SLOAD(SE, (j + 3) * KVBLK); SBAR();
    pv_d0(o, vb0 + (int)SHM_V, pa0, pa1, pa2, pa3); partialSM<DK>(pA0, pA1, m_reg, mnA, alA);
    __syncthreads(); SWAIT(); SWRITE(1, SO);
    RESC(alA); __syncthreads();
  }
  SBAR(); qkt<DK>(pB0, pB1, K_lds + SHM_K, qr, r32, hi);
  finishSM(pA0, pA1, alA, l_reg, pa0, pa1, pa2, pa3); SBAR();
  pv_d0(o, vb0, pa0, pa1, pa2, pa3); partialSM<DK>(pB0, pB1, m_reg, mnB, alB);
  __syncthreads(); RESC(alB);
  finishSM(pB0, pB1, alB, l_reg, pa0, pa1, pa2, pa3); SBAR();
  pv_d0(o, vb0 + (int)SHM_V, pa0, pa1, pa2, pa3);
  if (hi == 0) li_l[r32] = l_reg; asm volatile("s_waitcnt lgkmcnt(0)" ::: "memory");
  float rli[16];
#pragma unroll
  for (int r = 0; r < 16; ++r) rli[r] = __builtin_amdgcn_rcpf(li_l[crow(r, hi)]);
  float* Ow = Ob + (long)(wid * QBLK) * LDO;
#pragma unroll
  for (int r = 0; r < 16; ++r) { int orow = crow(r, hi);
#pragma unroll
    for (int d0 = 0; d0 < 4; ++d0) Ow[(long)orow * LDO + d0 * 32 + r32] = o[d0][r] * rli[r]; }
  __syncthreads();
#undef SLOAD
#undef SWRITE
#undef SWAIT
#undef RESC
}
}


#define XB_TMO      128
#define XB_XCNT(j)  (256  + 64 * (j))
#define XB_XSUB(j)  (1280 + 64 * (j))
#define XB_XGEN(j)  (2304 + 64 * (j))
#define XB_TOP      3328
#define XB_TOPGEN   3392
#define XCD_BAR_WORDS 3456
#define XB_SPIN_CAP (1u << 22)
__device__ __forceinline__ unsigned xb_ld(unsigned* p)              { return __hip_atomic_load(p, __ATOMIC_RELAXED, __HIP_MEMORY_SCOPE_AGENT); }
__device__ __forceinline__ unsigned xb_add(unsigned* p, unsigned v) { return __hip_atomic_fetch_add(p, v, __ATOMIC_RELAXED, __HIP_MEMORY_SCOPE_AGENT); }
__device__ __forceinline__ unsigned xb_xcc_id() { return (unsigned)__builtin_amdgcn_s_getreg((3 << 11) | 20) & 0xFu; }
#define XB_SPIN(cond, bar) do { unsigned _sp = 0; while (cond) { __builtin_amdgcn_s_sleep(1); \
    if ((++_sp & 255u) == 0u) { if (xb_ld(&(bar)[XB_TMO])) break; if (_sp > XB_SPIN_CAP) { atomicAdd(&(bar)[XB_TMO], 1u); break; } } } } while (0)
struct XcdBarrier { unsigned* bar; unsigned x; volatile LAS unsigned* st; };
__device__ __forceinline__ XcdBarrier xcd_barrier_post(unsigned* bar, volatile LAS unsigned* st) {
    XcdBarrier b; b.bar = bar; b.x = xb_xcc_id(); b.st = st;
    if (threadIdx.x == 0) (void)xb_add(&bar[XB_XCNT(b.x)], 1u);
    return b;
}
__device__ __forceinline__ void xcd_barrier_complete(unsigned* bar, unsigned x, unsigned& nloc, unsigned& nx) {
    const unsigned G = gridDim.x * gridDim.y * gridDim.z;
    unsigned sum, cnt, mine, sp = 0u;
    for (;;) {
        sum = 0u; cnt = 0u; mine = 0u;
#pragma unroll
        for (unsigned j = 0; j < 16; ++j) { const unsigned c = xb_ld(&bar[XB_XCNT(j)]); sum += c; cnt += (c > 0u) ? 1u : 0u; mine = (j == x) ? c : mine; }
        if (sum == G) break;
        __builtin_amdgcn_s_sleep(1);
        if ((++sp & 255u) == 0u) { if (xb_ld(&bar[XB_TMO])) break; if (sp > XB_SPIN_CAP) { atomicAdd(&bar[XB_TMO], 1u); break; } }
    }
    nloc = mine > 0u ? mine : 1u; nx = cnt > 0u ? cnt : 1u;
}
__device__ __forceinline__ void xcd_barrier(const XcdBarrier& b) {
    asm volatile("s_waitcnt vmcnt(0)" ::: "memory");
    __syncthreads();
    if (threadIdx.x == 0) {
        unsigned* bar = b.bar; unsigned bx = b.x; asm volatile("" : "+s"(bar), "+s"(bx));
        __builtin_amdgcn_s_waitcnt(0);
        unsigned nloc = b.st[0], nx = b.st[1];
        if (nloc == 0u) { xcd_barrier_complete(bar, bx, nloc, nx); b.st[0] = nloc; b.st[1] = nx; }
        const unsigned old = xb_add(&bar[XB_XSUB(bx)], 1u);
        const unsigned gen = old / nloc;
        if (old + 1u == (gen + 1u) * nloc) {
            __builtin_amdgcn_fence(__ATOMIC_RELEASE, "agent");
            asm volatile("s_waitcnt vmcnt(0)" ::: "memory");
            const unsigned og = xb_add(&bar[XB_TOP], 1u);
            const unsigned tg = og / nx;
            if (og + 1u == (tg + 1u) * nx) xb_add(&bar[XB_TOPGEN], 1u);
            else XB_SPIN(xb_ld(&bar[XB_TOPGEN]) == tg, bar);
            __builtin_amdgcn_fence(__ATOMIC_ACQUIRE, "agent");
            xb_add(&bar[XB_XGEN(bx)], 1u);
            asm volatile("s_waitcnt vmcnt(0)" ::: "memory");
        } else {
            XB_SPIN(xb_ld(&bar[XB_XGEN(bx)]) == gen, bar);
            __builtin_amdgcn_fence(__ATOMIC_ACQUIRE, "agent");
            asm volatile("s_waitcnt vmcnt(0)" ::: "memory");
        }
    }
    __syncthreads();
}


#ifndef DBG_STOP
#define DBG_STOP 0
#endif
constexpr size_t OUTN = (size_t)NB * SEQ * DM;
__device__ __forceinline__ void dbg_dump_f32(float* out, const float* src, size_t n, int gtid, int gn) {
    for (size_t i = gtid; i < OUTN; i += gn) { float s = 0.f; for (size_t k = i; k < n; k += OUTN) s += src[k]; out[i] = s; } }
__device__ __forceinline__ void dbg_dump_bf16(float* out, const bf16_t* src, size_t n, int gtid, int gn) {
    for (size_t i = gtid; i < OUTN; i += gn) { float s = 0.f; for (size_t k = i; k < n; k += OUTN) s += __uint_as_float((unsigned)src[k] << 16); out[i] = s; } }
#define DBG_AT(N, CALL) do { if (p.dbg == (N) && l == 0) { const int gtid = blockIdx.x * 512 + threadIdx.x, gn = gridDim.x * 512; CALL; return; } } while (0)

struct Params { const float* in[25]; float* out; unsigned char* ws; int dbg, pad; };
enum { I_X = 0, I_C, I_CTX, I_CCTX, I_WMOD, I_BMOD, I_NMIX, I_NFFN, I_WIN, I_LQ1, I_LK1, I_LQ2, I_LK2, I_SUBLN, I_QN, I_KN, I_POOLW, I_POOLS, I_GON, I_WOUT, I_WUP, I_CONVW, I_CONVB, I_WDN, I_FN };

constexpr int LDS_BYTES = 147456;

template <int MODE>
__device__ __forceinline__ void transpose_item(const float* W, int K, int N, bf16_t* WT, LAS float* scr, int item, int lane,
                                               const float* subln, const float* pools, const float* gon, float one_m_li) {
    const int nblk = N / 32, kb = item / nblk, nb = item % nblk, k0 = 64 * kb, n0 = 32 * nb;
    float wv[32];
#pragma unroll
    for (int i = 0; i < 32; ++i) { const int kk = 2 * i + (lane >> 5); wv[i] = W[(size_t)(k0 + kk) * N + n0 + (lane & 31)]; }
#pragma unroll
    for (int i = 0; i < 32; ++i) { const int kk = 2 * i + (lane >> 5); float w = wv[i];
        if (MODE == 1) { const int k = k0 + kk; const float s = (k < 768) ? subln[k & 127] * one_m_li : ((k < 1280) ? pools[k - 768] : gon[k - 1280]); w *= s; }
        scr[kk * 33 + (lane & 31)] = w; }
    asm volatile("s_waitcnt lgkmcnt(0)" ::: "memory");
    const int c = lane & 7;
#pragma unroll
    for (int j = 0; j < 4; ++j) { const int n = (lane >> 3) + 8 * j; const LAS float* s = scr + (8 * c) * 33 + n;
        u32x4 o; o.x = cvt_pk_bf16(s[0 * 33], s[1 * 33]); o.y = cvt_pk_bf16(s[2 * 33], s[3 * 33]); o.z = cvt_pk_bf16(s[4 * 33], s[5 * 33]); o.w = cvt_pk_bf16(s[6 * 33], s[7 * 33]);
        int nd = n0 + n; if (MODE == 2) { const int half = n0 >= DFF ? 1 : 0, rem = n0 - half * DFF; nd = (rem >> 7) * 256 + half * 128 + (rem & 127) + n; }
        *(u32x4*)(WT + (size_t)nd * K + k0 + 8 * c) = o; }
    asm volatile("s_waitcnt lgkmcnt(0)" ::: "memory");
}

template <int MODE>
__device__ __forceinline__ void transpose_matrix(const float* W, int K, int N, bf16_t* WT, LAS float* scr, int lane, int worker, int nworkers,
                                                 const float* subln, const float* pools, const float* gon, float one_m_li) {
    const int items = (K / 64) * (N / 32);
    for (int it = worker; it < items; it += nworkers) transpose_item<MODE>(W, K, N, WT, scr, it, lane, subln, pools, gon, one_m_li);
}
#define CONVERT_OUT_UP_DOWN(l_, worker_, nworkers_) do { const int l__ = (l_); const float li__ = l__ == 0 ? 0.2f : 0.35550906759f; LAS float* scr__ = (LAS float*)(L + wave * 8704); \
    transpose_matrix<1>(p.in[I_WOUT] + (size_t)l__ * MIXW * DM, MIXW, DM, (bf16_t*)(ws + WS_WOUT) + (size_t)l__ * DM * MIXW, scr__, lane, (worker_), (nworkers_), p.in[I_SUBLN] + l__ * 128, p.in[I_POOLS] + l__ * 512, p.in[I_GON] + l__ * 768, 1.f - li__); \
    transpose_matrix<2>(p.in[I_WUP] + (size_t)l__ * DM * DFF2, DM, DFF2, (bf16_t*)(ws + WS_WUP) + (size_t)l__ * DFF2 * DM, scr__, lane, (worker_), (nworkers_), nullptr, nullptr, nullptr, 0.f); \
    transpose_matrix<0>(p.in[I_WDN] + (size_t)l__ * DFF * DM, DFF, DM, (bf16_t*)(ws + WS_WDN) + (size_t)l__ * DM * DFF, scr__, lane, (worker_), (nworkers_), nullptr, nullptr, nullptr, 0.f); } while (0)
#define CONVERT_IN(l_, worker_, nworkers_) do { const int l__ = (l_); LAS float* scr__ = (LAS float*)(L + wave * 8704); \
    transpose_matrix<0>(p.in[I_WIN] + (size_t)l__ * DM * INC, DM, INC, (bf16_t*)(ws + WS_WIN) + (size_t)l__ * INC * DM, scr__, lane, (worker_), (nworkers_), nullptr, nullptr, nullptr, 0.f); } while (0)

__device__ __forceinline__ void norm_phase(float* X, bf16_t* H, const float* gain, const float* mod_l, int shift_off, int scale_off, int gw, int NGW, int lane, bool skip_ctx, const float* part, const float* pgate,
                                           const float* xlat  , const float* xctx  ) {
    for (int m = gw; m < MROWS; m += NGW) {
        const int b = m / TOK, t = m - b * TOK; const int r = t < CTX ? 4 : b;
        if (skip_ctx && t < CTX) continue;
        float* xr = X + (size_t)m * DM + lane * 4;
        const float* xs = xr;
        if (t < CTX) { if (xctx) xs = xctx + ((size_t)b * CTX + t) * DM + lane * 4; } else { if (xlat) xs = xlat + ((size_t)b * SEQ + (t - CTX)) * DM + lane * 4; }
        f32x4 v[8]; float ss = 0.f;
#pragma unroll
        for (int j = 0; j < 8; ++j) v[j] = *(const f32x4*)(xs + j * 256);
        if (part != nullptr && t < CTX) {
            const float* pr = part + (size_t)(b * 256 + t) * DM + lane * 4;
#pragma unroll
            for (int j = 0; j < 8; ++j) { f32x4 a = *(const f32x4*)(pr + j * 256);
#pragma unroll
                for (int ks = 1; ks < 8; ++ks) a += *(const f32x4*)(pr + (size_t)ks * 1024 * DM + j * 256);
                v[j] += *(const f32x4*)(pgate + lane * 4 + j * 256) * a; *(f32x4*)(xr + j * 256) = v[j]; }
        }
#pragma unroll
        for (int j = 0; j < 8; ++j) ss += (v[j].x * v[j].x + v[j].y * v[j].y) + (v[j].z * v[j].z + v[j].w * v[j].w);
        const float rstd = 1.0f / sqrtf(wave_sum(ss) * (1.f / DM) + EPS);
        const float* mr = mod_l + (size_t)r * NMOD6 + lane * 4;
        bf16_t* hr = H + (size_t)m * DM + lane * 4;
#pragma unroll
        for (int j = 0; j < 8; ++j) { const f32x4 g = *(const f32x4*)(gain + lane * 4 + j * 256), sc = *(const f32x4*)(mr + scale_off + j * 256), sh = *(const f32x4*)(mr + shift_off + j * 256);
            const f32x4 y = (v[j] * rstd * g) * (1.f + sc) + sh;
            u32x2 w; w.x = cvt_pk_bf16(y.x, y.y); w.y = cvt_pk_bf16(y.z, y.w); *(u32x2*)(hr + j * 256) = w; }
    }
}

__global__ void __launch_bounds__(512, 2) fwd_megakernel(Params p) {
    extern __shared__ __attribute__((aligned(16))) unsigned char lds[];
    cg::grid_group grid = cg::this_grid();
    const int G = gridDim.x, NGW = G * 8;
#define FRESH_IDS() int tid = threadIdx.x; asm volatile("" : "+v"(tid)); const int lane = tid & 63, wave = __builtin_amdgcn_readfirstlane(tid >> 6); int bid = blockIdx.x; asm volatile("" : "+s"(bid)); const int gw = bid * 8 + wave; (void)lane; (void)gw;
    unsigned char* ws = p.ws;
    float* MOD = (float*)(ws + WS_MOD);
    float* X = (float*)(ws + WS_X);
    bf16_t* H = (bf16_t*)(ws + WS_H);
    bf16_t* ACT = (bf16_t*)(ws + WS_ACT);
    bf16_t* U = (bf16_t*)(ws + WS_U);
    bf16_t* PROJ = (bf16_t*)(ws + WS_PROJ);
    float* AO = (float*)(ws + WS_AO);
    bf16_t* MRG = (bf16_t*)(ws + WS_MRG);
    float* PART = (float*)(ws + WS_PART);
    bf16_t* EDGE = (bf16_t*)(ws + WS_U + 190 * MiB);
    LAS unsigned char* L = (LAS unsigned char*)lds;
    volatile LAS unsigned* MISC = (volatile LAS unsigned*)(L + LDS_BYTES - 64);
    if (threadIdx.x < 16) MISC[threadIdx.x] = 0u;
    __syncthreads();
    if (blockIdx.x == 0 && threadIdx.x < 64) { unsigned* bw = (unsigned*)(ws + WS_CTL);
        for (int i = threadIdx.x; i < XCD_BAR_WORDS; i += 64) __hip_atomic_store(bw + i, 0u, __ATOMIC_RELAXED, __HIP_MEMORY_SCOPE_AGENT);
        asm volatile("s_waitcnt vmcnt(0)" ::: "memory"); }
    __syncthreads();
    grid.sync();
    XcdBarrier xbar = xcd_barrier_post((unsigned*)(ws + WS_CTL), MISC);
#define GRID_SYNC() xcd_barrier(xbar)

    {
        FRESH_IDS();
        LAS float* scv = (LAS float*)(L + 69632);
        LAS float* red = (LAS float*)(L + 69632 + 40960);
        for (int i = tid; i < 5 * DM; i += 512) { const int r = i >> 11, k = i & 2047; const float v = r < 4 ? p.in[I_C][r * DM + k] : p.in[I_CCTX][k]; scv[i] = silu_f(v); }
        __syncthreads();
        for (int task = bid; task < 192; task += G) {
            const int l = task / 96, j0 = (task % 96) * 128;
            const float* wp = p.in[I_WMOD] + ((size_t)l * DM + wave * 256) * NMOD6 + j0 + lane * 2;
            f32x2 a0 = {0.f, 0.f}, a1 = a0, a2 = a0, a3 = a0, a4 = a0;
#pragma unroll 16
            for (int k = 0; k < 256; ++k) { const f32x2 w = *(const f32x2*)(wp + (size_t)k * NMOD6); const int kk = wave * 256 + k;
                a0 += scv[kk] * w; a1 += scv[2048 + kk] * w; a2 += scv[4096 + kk] * w; a3 += scv[6144 + kk] * w; a4 += scv[8192 + kk] * w; }
            LAS float* rw = red + wave * 640 + lane * 2;
            rw[0] = a0.x; rw[1] = a0.y; rw[128] = a1.x; rw[129] = a1.y; rw[256] = a2.x; rw[257] = a2.y; rw[384] = a3.x; rw[385] = a3.y; rw[512] = a4.x; rw[513] = a4.y;
            __syncthreads();
            for (int i = tid; i < 640; i += 512) { const int r = i >> 7, jj = i & 127; float s = p.in[I_BMOD][l * NMOD6 + j0 + jj];
#pragma unroll
                for (int q = 0; q < 8; ++q) s += red[q * 640 + i];
                MOD[((size_t)l * 5 + r) * NMOD6 + j0 + jj] = s; }
            __syncthreads();
        }
        {
            const bool defer = (G == 256);
            CONVERT_IN(0, gw, NGW);
            { LAS float* scr = (LAS float*)(L + wave * 8704);
              for (int it = gw; it < 64; it += NGW) { const int l2 = it >> 5, r = it & 31, g = r >> 3;
                  transpose_item<0>(p.in[I_POOLW] + ((size_t)l2 * 4 + g) * 16384, 128, 128, (bf16_t*)(ws + WS_WPOOL) + ((size_t)l2 * 4 + g) * 16384, scr, r & 7, lane, nullptr, nullptr, nullptr, 0.f); } }
            if (!defer) { CONVERT_IN(1, gw, NGW); CONVERT_OUT_UP_DOWN(0, gw, NGW); CONVERT_OUT_UP_DOWN(1, gw, NGW); }
        }
    }
    GRID_SYNC();

    for (int l = 0; l < 2; ++l) {
        const bool last = (l == 1);
        const float lambda_init = l == 0 ? 0.2f : 0.35550906759f;
        const float* mod_l = MOD + (size_t)l * 5 * NMOD6;
        { FRESH_IDS(); norm_phase(X, H, p.in[I_NMIX] + l * DM, mod_l, 0, DM, gw, NGW, lane, false, (l == 1 && G == 256) ? PART : nullptr, MOD + 4 * NMOD6 + 5 * DM, l == 0 ? p.in[I_X] : nullptr, l == 0 ? p.in[I_CTX] : nullptr); }
        GRID_SYNC();
        { FRESH_IDS(); pg8::Gemm g{H, (const bf16_t*)(ws + WS_WIN) + (size_t)l * INC * DM, MROWS, INC, DM}; pg8::StaticOrder S; S.init(MROWS / 256, INC / 256, G, bid, 0, DM / 64);
          pg8::EpiBf16 E{PROJ, INC}; pg8::gemm_phase<pg8::EpiBf16, pg8::StaticOrder, true, true>(L, g, S, E, tid);
          if (l == 0 && G == 256 && bid >= 64) { __syncthreads(); CONVERT_OUT_UP_DOWN(0, (bid - 64) * 8 + wave, 192 * 8); } }
        GRID_SYNC();
        {
            FRESH_IDS();
            const float* qn = p.in[I_QN] + l * 128; const float* kn = p.in[I_KN] + l * 128;
            for (int m = gw; m < MROWS; m += NGW) {
                const int b = m / TOK, t = m - b * TOK; const bool lat = t >= CTX; const int s = t - CTX; const float prow = (float)(s >> 6), pcol = (float)(s & 63);
                bf16_t* pr = PROJ + (size_t)m * INC;
                if (lat) {
                    for (int pc = lane; pc < 96; pc += 64) { const int blk = pc >> 1, c = pc & 1; bf16_t* a = pr + blk * 32 + c * 8;
                        const float pos = (blk & 1) ? pcol : prow;
                        u32x4 va = *(const u32x4*)a, vb = *(const u32x4*)(a + 16); u32x4 oa, ob;
#pragma unroll
                        for (int e2 = 0; e2 < 4; ++e2) { float y1[2], y2[2];
#pragma unroll
                            for (int h = 0; h < 2; ++h) { const int i = c * 8 + e2 * 2 + h; const float x1 = h ? bfhi(va[e2]) : bflo(va[e2]), x2 = h ? bfhi(vb[e2]) : bflo(vb[e2]);
                                const float fr_ = __builtin_amdgcn_exp2f(-(float)i * (13.287712379549449f / 16.f)) * 0.15915494309189535f; float rev = pos * fr_; rev -= floorf(rev);
                                const float sn = __builtin_amdgcn_sinf(rev), cs = __builtin_amdgcn_cosf(rev);
                                y1[h] = x1 * cs - x2 * sn; y2[h] = x2 * cs + x1 * sn; }
                            oa[e2] = cvt_pk_bf16(y1[0], y1[1]); ob[e2] = cvt_pk_bf16(y2[0], y2[1]); }
                        *(u32x4*)a = oa; *(u32x4*)(a + 16) = ob; }
                }
                { const int head = lane >> 3, sub = lane & 7, blk64 = sub >> 2, c = sub & 3; bf16_t* a = pr + C_GQ + head * 128 + blk64 * 64 + c * 8;
                  const float* gp = (head < 6 ? qn : kn) + blk64 * 64 + c * 8; const float pos = blk64 ? pcol : prow;
                  u32x4 va = *(const u32x4*)a, vb = *(const u32x4*)(a + 32); float x1[8], x2[8]; float ss = 0.f;
#pragma unroll
                  for (int e2 = 0; e2 < 4; ++e2) { x1[2 * e2] = bflo(va[e2]); x1[2 * e2 + 1] = bfhi(va[e2]); x2[2 * e2] = bflo(vb[e2]); x2[2 * e2 + 1] = bfhi(vb[e2]); }
#pragma unroll
                  for (int e = 0; e < 8; ++e) ss += x1[e] * x1[e] + x2[e] * x2[e];
                  ss += __shfl_xor(ss, 1); ss += __shfl_xor(ss, 2); ss += __shfl_xor(ss, 4);
                  const float rstd = 1.0f / sqrtf(ss * (1.f / 128.f) + EPS);
                  u32x4 oa, ob;
#pragma unroll
                  for (int e2 = 0; e2 < 4; ++e2) { float y1[2], y2[2];
#pragma unroll
                      for (int h = 0; h < 2; ++h) { const int e = e2 * 2 + h, i = c * 8 + e; const float a1 = x1[e] * rstd * gp[e], a2 = x2[e] * rstd * gp[32 + e];
                          float sn = 0.f, cs = 1.f;
                          if (lat) { const float fr_ = __builtin_amdgcn_exp2f(-(float)i * (13.287712379549449f / 32.f)) * 0.15915494309189535f; float rev = pos * fr_; rev -= floorf(rev);
                              sn = __builtin_amdgcn_sinf(rev); cs = __builtin_amdgcn_cosf(rev); }
                          y1[h] = a1 * cs - a2 * sn; y2[h] = a2 * cs + a1 * sn; }
                      oa[e2] = cvt_pk_bf16(y1[0], y1[1]); ob[e2] = cvt_pk_bf16(y2[0], y2[1]); }
                  *(u32x4*)a = oa; *(u32x4*)(a + 32) = ob; }
            }
        }
        GRID_SYNC();
        {
            FRESH_IDS();
            float* AO1 = AO; float* AO2 = AO + (size_t)MROWS * 768; float* AOG = AO + (size_t)2 * MROWS * 768;
            for (int step = 0; step < 8; ++step) {
                int u = -1;
                if (G == 256) {
                    if (bid < 192) { const int x = bid & 7, sl = bid >> 3;
                        if (step == 0) { const int bq = sl / 6, hq = sl % 6; u = bq * 48 + hq * 8 + ((x + 8 - hq) & 7); }
                        else if (step == 1) { const int bq = sl / 6, h = sl % 6;
                            u = 192 + bid; (void)bq; }
                        else if (step == 2 && !last && bid < 72) u = 576 + bid; }
                    else { if (step < 3) u = 192 + 192 + (bid - 192) * 3 + step; }
                } else { const int nu = last ? 576 : 648; const int uu = bid + step * G; if (uu < nu) u = uu; }
                if (u < 0) continue;
                int tid2 = tid; asm volatile("" : "+v"(tid2));
                int b, h, half = 0, qb = 0; const bool isctx = u >= 576; bool gqa;
                if (u < 192) { b = u / 48; const int rem = u % 48; h = rem >> 3; qb = rem & 7; gqa = true; }
                else if (u < 576) { const int v = u - 192; b = v / 96; const int rem = v % 96; h = rem >> 4; half = (rem >> 3) & 1; qb = rem & 7; gqa = false; }
                else if (u < 600) { const int v = u - 576; b = v / 6; h = v % 6; gqa = true; }
                else { const int v = u - 600; b = v / 12; const int rem = v % 12; h = rem >> 1; half = rem & 1; gqa = false; }
                const size_t r0 = (size_t)b * TOK, rq = isctx ? r0 : r0 + CTX + qb * 256; const int seq = isctx ? CTX : TOK;
                if (gqa) { const int kvh = h / 3;
                    att::attn_unit<128>(PROJ + rq * INC + C_GQ + h * 128, PROJ + r0 * INC + C_GK + kvh * 128, PROJ + r0 * INC + C_GV + kvh * 128, AOG + rq * 768 + h * 128, seq, (char*)lds, tid2);
                } else {
                    att::attn_unit<64>(PROJ + rq * INC + C_DAQ + h * 128 + half * 64, PROJ + r0 * INC + C_DAK + h * 128 + half * 64, PROJ + r0 * INC + C_DAV + h * 128, (half ? AO2 : AO1) + rq * 768 + h * 128, seq, (char*)lds, tid2);
                }
            }
        }
        {
            FRESH_IDS();
            const bool fill = (G != 256) || (bid < 192);
            const int pool_first = (G == 256) ? bid : bid, pool_stride = (G == 256) ? 192 : G;
            if (fill) {
                __syncthreads();
                const bf16_t* WP = (const bf16_t*)(ws + WS_WPOOL) + (size_t)l * 4 * 16384;
                LAS unsigned* tin = (LAS unsigned*)L;
                LAS unsigned char* tout = L + 20480;
                for (int it = pool_first; it < 576; it += pool_stride) {
                    const int tile = it >> 2, g = it & 3, m0 = tile * 64, b = m0 / TOK, t0 = m0 - b * TOK; const bool isctx = t0 < CTX;
                    if (last && isctx) continue;
                    const int slo = isctx ? 0 : CTX, shi = isctx ? CTX : TOK;
                    for (int idx = tid; idx < 1280; idx += 512) { const int row = idx >> 4, ch = idx & 15, t = t0 - 8 + row;
                        u32x4 v = {0u, 0u, 0u, 0u};
                        if (t >= slo && t < shi) v = *(const u32x4*)(PROJ + (size_t)(b * TOK + t) * INC + C_POOL + g * 128 + ch * 8);
                        *(LAS u32x4*)(tin + row * 64 + ch * 4) = v; }
                    bf16x8 wfr[4][4];
#pragma unroll
                    for (int q = 0; q < 4; ++q)
#pragma unroll
                        for (int ks = 0; ks < 4; ++ks) wfr[q][ks] = *(const bf16x8*)(WP + (size_t)g * 16384 + (size_t)(((wave & 1) * 4 + q) * 16 + (lane & 15)) * 128 + ks * 32 + (lane >> 4) * 8);
                    __syncthreads();
                    { const int w = 2 << g, hw = w >> 1, Tn = shi - slo, p0 = t0 - slo;
    #pragma unroll 1
                      for (int rr = 0; rr < 8; ++rr) { const int r = wave * 8 + rr, pp = p0 + r;
                          int lo = pp - hw; lo = lo < 0 ? 0 : lo; int hi2 = pp - hw + w; hi2 = hi2 > Tn ? Tn : hi2;
                          float s0 = 0.f, s1 = 0.f;
                          for (int j = lo; j < hi2; ++j) { const unsigned u = tin[(j - p0 + 8) * 64 + lane]; s0 += bflo(u); s1 += bfhi(u); }
                          const unsigned uc = tin[(r + 8) * 64 + lane]; const float inv = 1.0f / (float)(hi2 - lo);
                          *(LAS unsigned*)(tout + r * 272 + lane * 4) = cvt_pk_bf16(s0 * inv - bflo(uc), s1 * inv - bfhi(uc)); } }
                    __syncthreads();
                    { const int rb = wave >> 1, fr = lane & 15, fq = lane >> 4;
    #pragma unroll
                      for (int q = 0; q < 4; ++q) { const int nb = (wave & 1) * 4 + q; f32x4 acc = {0.f, 0.f, 0.f, 0.f};
    #pragma unroll
                          for (int ks = 0; ks < 4; ++ks) { const bf16x8 af = *(const LAS bf16x8*)(tout + (rb * 16 + fr) * 272 + (ks * 32 + fq * 8) * 2);
                              acc = __builtin_amdgcn_mfma_f32_16x16x32_bf16(wfr[q][ks], af, acc, 0, 0, 0); }
                          u32x2 o; o.x = cvt_pk_bf16(acc[0], acc[1]); o.y = cvt_pk_bf16(acc[2], acc[3]);
                          *(u32x2*)(MRG + (size_t)(m0 + rb * 16 + fr) * MIXW + 768 + g * 128 + nb * 16 + 4 * fq) = o; } }
                    __syncthreads();
                }

                if (l == 0 && G == 256) CONVERT_IN(1, bid * 8 + wave, 192 * 8);
            }
        }
        GRID_SYNC();
        {
            FRESH_IDS();
            const float* AO1 = AO; const float* AO2 = AO + (size_t)MROWS * 768; const float* AOG = AO + (size_t)2 * MROWS * 768;
            const float s1 = wave_sum(p.in[I_LQ1][l * 64 + lane] * p.in[I_LK1][l * 64 + lane]), s2 = wave_sum(p.in[I_LQ2][l * 64 + lane] * p.in[I_LK2][l * 64 + lane]);
            const float lam = expf(s1) - expf(s2) + lambda_init;
            for (int m = gw; m < MROWS; m += NGW) {
                const int b = m / TOK, t = m - b * TOK; if (last && t < CTX) continue;
                bf16_t* mr = MRG + (size_t)m * MIXW + lane * 2;
                f32x2 da[6], db[6], v[6];
#pragma unroll
                for (int h = 0; h < 6; ++h) { da[h] = *(const f32x2*)(AO1 + (size_t)m * 768 + h * 128 + lane * 2); db[h] = *(const f32x2*)(AO2 + (size_t)m * 768 + h * 128 + lane * 2); v[h] = *(const f32x2*)(AOG + (size_t)m * 768 + h * 128 + lane * 2); }
                float ssd[6], ss = 0.f;
#pragma unroll
                for (int h = 0; h < 6; ++h) { da[h] = da[h] - lam * db[h]; ssd[h] = da[h].x * da[h].x + da[h].y * da[h].y; ss += v[h].x * v[h].x + v[h].y * v[h].y; }
#pragma unroll
                for (int o = 1; o < 64; o <<= 1) {
#pragma unroll
                    for (int h = 0; h < 6; ++h) ssd[h] += __shfl_xor(ssd[h], o);
                    ss += __shfl_xor(ss, o); }
#pragma unroll
                for (int h = 0; h < 6; ++h) { const float rs = 1.0f / sqrtf(ssd[h] * (1.f / 128.f) + EPS); *(unsigned*)(mr + h * 128) = cvt_pk_bf16(da[h].x * rs, da[h].y * rs); }
                const float rstd = 1.0f / sqrtf(ss * (1.f / 768.f) + EPS);
#pragma unroll
                for (int j = 0; j < 6; ++j) *(unsigned*)(mr + 1280 + j * 128) = cvt_pk_bf16(v[j].x * rstd, v[j].y * rstd);
            }
        }
        GRID_SYNC();
        { FRESH_IDS(); pg8::Gemm g{MRG, (const bf16_t*)(ws + WS_WOUT) + (size_t)l * DM * MIXW, MROWS, DM, MIXW}; pg8::StaticOrder S; S.init(last ? 32 : 36, DM / 256, G, bid, last ? 1 : 0, MIXW / 64, (!last && G == 256) ? 1 : 0);
          pg8::EpiResid E{X, mod_l + 2 * DM, PART, l == 0 ? p.in[I_X] : nullptr, l == 0 ? p.in[I_CTX] : nullptr}; pg8::gemm_phase<pg8::EpiResid, pg8::StaticOrder, true, true>(L, g, S, E, tid); }
        GRID_SYNC();
        { FRESH_IDS(); norm_phase(X, H, p.in[I_NFFN] + l * DM, mod_l, 3 * DM, 4 * DM, gw, NGW, lane, last, (l == 0 && G == 256) ? PART : nullptr, mod_l + 4 * NMOD6 + 2 * DM, nullptr, (l == 0 && G == 256) ? p.in[I_CTX] : nullptr); }
        GRID_SYNC();
        { FRESH_IDS(); pg8::Gemm g{H, (const bf16_t*)(ws + WS_WUP) + (size_t)l * DFF2 * DM, MROWS, DFF2, DM}; pg8::StaticOrder S; S.init(last ? 32 : 36, DFF2 / 256, G, bid, last ? 1 : 0, DM / 64);
          pg8::EpiConvAct E{ACT, EDGE, p.in[I_CONVW] + (size_t)l * 3 * DFF2, p.in[I_CONVB] + (size_t)l * DFF2, (LAS float*)(L + 131072)}; pg8::gemm_phase<pg8::EpiConvAct, pg8::StaticOrder, true, true>(L, g, S, E, tid);
          if (l == 0 && G == 256 && bid >= 48) { __syncthreads(); CONVERT_OUT_UP_DOWN(1, (bid - 48) * 8 + wave, 208 * 8); } }
        GRID_SYNC();
        {
            FRESH_IDS();
            pg8::StaticOrder S; S.init(last ? 32 : 36, DM / 256, G, bid, last ? 1 : 0, DFF / 64, (!last && G == 256) ? 1 : 0);
            const float* cw = p.in[I_CONVW] + (size_t)l * 3 * DFF2; const float* cb = p.in[I_CONVB] + (size_t)l * DFF2;
            pg8::Unit uu;
            for (int i = 0; S.next(i, uu); ++i) { const int pm = uu.pm, j = pm % 9 - 1; if (j < 0) continue;
                for (int idx = tid; idx < 2 * 704; idx += 512) { const int which = idx >= 704 ? 1 : 0, col = (idx - which * 704) * 8;
                    if (which == 0 ? (j == 0) : (j == 7)) continue;
                    const bf16_t* ru = which == 0 ? EDGE + (size_t)((pm - 1) * 4 + 3) * DFF2 : EDGE + (size_t)(pm * 4 + 2) * DFF2;
                    const bf16_t* rm = which == 0 ? EDGE + (size_t)(pm * 4 + 0) * DFF2 : EDGE + (size_t)(pm * 4 + 3) * DFF2;
                    const bf16_t* rd = which == 0 ? EDGE + (size_t)(pm * 4 + 1) * DFF2 : EDGE + (size_t)((pm + 1) * 4 + 0) * DFF2;
                    const u32x4 gu = *(const u32x4*)(ru + col), gm = *(const u32x4*)(rm + col), gd = *(const u32x4*)(rd + col);
                    const u32x4 vu = *(const u32x4*)(ru + DFF + col), vm = *(const u32x4*)(rm + DFF + col), vd = *(const u32x4*)(rd + DFF + col);
                    u32x4 o;
#pragma unroll
                    for (int e2 = 0; e2 < 4; ++e2) { float res[2];
                        const f32x2 wg0 = *(const f32x2*)(cw + col + e2 * 2), wg1 = *(const f32x2*)(cw + DFF2 + col + e2 * 2), wg2 = *(const f32x2*)(cw + 2 * DFF2 + col + e2 * 2), bg = *(const f32x2*)(cb + col + e2 * 2);
                        const f32x2 wv0 = *(const f32x2*)(cw + DFF + col + e2 * 2), wv1 = *(const f32x2*)(cw + DFF2 + DFF + col + e2 * 2), wv2 = *(const f32x2*)(cw + 2 * DFF2 + DFF + col + e2 * 2), bv = *(const f32x2*)(cb + DFF + col + e2 * 2);
#pragma unroll
                        for (int h = 0; h < 2; ++h) {
                            const float g0 = h ? bfhi(gu[e2]) : bflo(gu[e2]), g1 = h ? bfhi(gm[e2]) : bflo(gm[e2]), g2 = h ? bfhi(gd[e2]) : bflo(gd[e2]);
                            const float v0 = h ? bfhi(vu[e2]) : bflo(vu[e2]), v1 = h ? bfhi(vm[e2]) : bflo(vm[e2]), v2 = h ? bfhi(vd[e2]) : bflo(vd[e2]);
                            const float gg = wg0[h] * g0 + wg1[h] * g1 + wg2[h] * g2 + bg[h];
                            const float vv = wv0[h] * v0 + wv1[h] * v1 + wv2[h] * v2 + bv[h];
                            res[h] = silu_f(gg) * vv; }
                        o[e2] = cvt_pk_bf16(res[0], res[1]); }
                    *(u32x4*)(ACT + (size_t)(pm * 256 + (which ? 255 : 0)) * DFF + col) = o; } }
            asm volatile("s_waitcnt vmcnt(0)" ::: "memory"); __syncthreads();
        }
        { FRESH_IDS(); pg8::Gemm g{ACT, (const bf16_t*)(ws + WS_WDN) + (size_t)l * DM * DFF, MROWS, DM, DFF}; pg8::StaticOrder S; S.init(last ? 32 : 36, DM / 256, G, bid, last ? 1 : 0, DFF / 64, (!last && G == 256) ? 1 : 0);
          pg8::EpiResid E{X, mod_l + 5 * DM, PART, nullptr, nullptr}; pg8::gemm_phase<pg8::EpiResid, pg8::StaticOrder, true, true>(L, g, S, E, tid); }
        GRID_SYNC();
    }
    { FRESH_IDS();
    for (int i = gw; i < NB * SEQ; i += NGW) { const int b = i / SEQ, s = i - b * SEQ; const float* xr = X + ((size_t)b * TOK + CTX + s) * DM + lane * 4;
        f32x4 v[8]; float ss = 0.f;
#pragma unroll
        for (int j = 0; j < 8; ++j) { v[j] = *(const f32x4*)(xr + j * 256); ss += (v[j].x * v[j].x + v[j].y * v[j].y) + (v[j].z * v[j].z + v[j].w * v[j].w); }
        const float rstd = 1.0f / sqrtf(wave_sum(ss) * (1.f / DM) + EPS);
        float* orow = p.out + (size_t)i * DM + lane * 4;
#pragma unroll
        for (int j = 0; j < 8; ++j) { const f32x4 g = *(const f32x4*)(p.in[I_FN] + lane * 4 + j * 256); *(f32x4*)(orow + j * 256) = v[j] * rstd * g; } } }
}

extern "C" void kernel_launch(void* const* d_in, const int* in_sizes, int n_in, void* d_out, int out_size, void* d_ws, size_t ws_size, hipStream_t stream) {
    static int grid_blocks = 0;
    if (grid_blocks == 0) {
        if (n_in != 25 || ws_size < WS_END) { fprintf(stderr, "kernel_launch: n_in %d ws %zu (need %zu)\n", n_in, ws_size, (size_t)WS_END); grid_blocks = -1; return; }
        int dev = 0, cus = 0, per_cu = 0;
        hipGetDevice(&dev); hipDeviceGetAttribute(&cus, hipDeviceAttributeMultiprocessorCount, dev);
        if (hipFuncSetAttribute((const void*)fwd_megakernel, hipFuncAttributeMaxDynamicSharedMemorySize, LDS_BYTES) != hipSuccess) { fprintf(stderr, "kernel_launch: hipFuncSetAttribute failed\n"); grid_blocks = -1; return; }
        if (hipOccupancyMaxActiveBlocksPerMultiprocessor(&per_cu, (const void*)fwd_megakernel, 512, LDS_BYTES) != hipSuccess || per_cu < 1) { fprintf(stderr, "kernel_launch: occupancy query says %d\n", per_cu); per_cu = 1; }
        (void)hipGetLastError();
        grid_blocks = cus * 1;
        fprintf(stderr, "kernel_launch: cus %d per_cu %d grid %d\n", cus, per_cu, grid_blocks);
    }
    if (grid_blocks < 0) return;
    Params p{};
    for (int i = 0; i < 25; ++i) p.in[i] = (const float*)d_in[i];
    p.out = (float*)d_out; p.ws = (unsigned char*)d_ws; p.dbg = DBG_STOP;
    void* args[] = {&p};
    hipError_t e = hipLaunchCooperativeKernel((const void*)fwd_megakernel, dim3(grid_blocks), dim3(512), args, LDS_BYTES, stream);
    if (e != hipSuccess) fprintf(stderr, "cooperative launch failed: %s (grid %d)\n", hipGetErrorString(e), grid_blocks);
}
```
